# Optimizing an MI355X kernel written in HIP

```python
import jax, jax.numpy as jnp
from jax import lax
import numpy as np

D_MODEL = 1024
BATCH = 16
SEQ = 2048
DEPTH = 1

GRID_W = 64
HEAD_DIM = 64
RWKV_HEADS = 8
RWKV_WIDTH = RWKV_HEADS * HEAD_DIM
DECAY_RANK = 64
ICLR_RANK = 64
GATE_RANK = 128
NA_HEADS = 8
NA_WIDTH = NA_HEADS * HEAD_DIM
NA_MAX_WIN_ROWS = 8
NA_WIN_COLS = 16
N_GROUPS = 4
EXPERTS_PER_GROUP = 8
N_EXPERTS = N_GROUPS * EXPERTS_PER_GROUP
D_EXPERT = 256
TOP_K_IN_GROUP = 2
RMS_EPS = 1e-6
GN_EPS = 64e-5
NEG_INF = -1e30
RWKV_COLS = 3 * RWKV_WIDTH + 2 * DECAY_RANK + 2 * ICLR_RANK + GATE_RANK
NA_COLS = 3 * NA_WIDTH
GATE_COLS = 2 * D_MODEL
IN_COLS = RWKV_COLS + NA_COLS + GATE_COLS
RWKV_SPLITS = (RWKV_WIDTH, 2 * RWKV_WIDTH, 3 * RWKV_WIDTH,
               3 * RWKV_WIDTH + DECAY_RANK, 3 * RWKV_WIDTH + 2 * DECAY_RANK,
               3 * RWKV_WIDTH + 2 * DECAY_RANK + ICLR_RANK,
               3 * RWKV_WIDTH + 2 * DECAY_RANK + 2 * ICLR_RANK)
IN_SPLITS = (RWKV_COLS, RWKV_COLS + NA_WIDTH, RWKV_COLS + 2 * NA_WIDTH, RWKV_COLS + 3 * NA_WIDTH)

kernel_name = 'hybrid_rwkv7_natten2d_hiermoe_block'


def rmsnorm(x, g):
    x32 = x.astype(jnp.float32)
    y = x32 * lax.rsqrt(jnp.mean(x32 * x32, axis=-1, keepdims=True) + RMS_EPS)
    return (y * g).astype(x.dtype)


def centred_token_shift(p, mu_prev, mu_next):
    prev = jnp.pad(p, ((0, 0), (1, 0), (0, 0)))[:, :-1]
    nxt = jnp.pad(p, ((0, 0), (0, 1), (0, 0)))[:, 1:]
    return p + mu_prev * (prev - p) + mu_next * (nxt - p)


def rwkv_log_decay(lora, w0, up):
    w_raw = (w0 + jnp.tanh(lora) @ up).astype(jnp.float32)
    return -jnp.exp(-jax.nn.softplus(-w_raw) - 0.5)


def rwkv_step(S, inp):
    r_t, w_t, k_t, v_t, kk_t, a_t = inp
    sa = jnp.einsum('dbhij,dbhj->dbhi', S, -kk_t)
    S = (S * w_t[..., None, :] + sa[..., :, None] * (kk_t * a_t)[..., None, :]
         + v_t[..., :, None] * k_t[..., None, :])
    y = jnp.einsum('dbhij,dbhj->dbhi', S, r_t)
    return S, y


def rwkv7_bidirectional(p, mu_prev, mu_next, w0_f, w_up_f, w0_b, w_up_b, a0_f, a_up_f,
                        a0_b, a_up_b, g_up, k_k, k_a, r_k, lnx_g, lnx_b):
    B, T, _ = p.shape
    dt = p.dtype
    p = centred_token_shift(p, mu_prev, mu_next)
    r, k, v, wl_f, wl_b, al_f, al_b, gl = jnp.split(p, RWKV_SPLITS, axis=-1)
    lw_f = rwkv_log_decay(wl_f, w0_f, w_up_f)
    lw_b = rwkv_log_decay(wl_b, w0_b, w_up_b)
    a_f = jax.nn.sigmoid(a0_f + al_f @ a_up_f)
    a_b = jax.nn.sigmoid(a0_b + al_b @ a_up_b)
    g = jax.nn.sigmoid(gl) @ g_up

    def heads(t):
        return t.reshape(B, T, RWKV_HEADS, HEAD_DIM).astype(jnp.float32)

    r_h, v_h = heads(r), heads(v)
    kk = heads(k * k_k)
    kk = kk * lax.rsqrt(jnp.sum(kk * kk, axis=-1, keepdims=True) + 1e-12)
    k_f = heads(k * (1.0 + (a_f - 1.0) * k_a))
    k_b = heads(k * (1.0 + (a_b - 1.0) * k_a))
    a_fh, a_bh = heads(a_f), heads(a_b)
    w_fh, w_bh = jnp.exp(heads(lw_f)), jnp.exp(heads(lw_b))

    def both(f, b):
        return jnp.stack([f, jnp.flip(b, axis=1)], axis=0).transpose(2, 0, 1, 3, 4)

    xs = (both(r_h, r_h), both(w_fh, w_bh), both(k_f, k_b), both(v_h, v_h),
          both(kk, kk), both(a_fh, a_bh))
    S0 = jnp.zeros((2, B, RWKV_HEADS, HEAD_DIM, HEAD_DIM), jnp.float32)
    _, ys = lax.scan(rwkv_step, S0, xs)
    y_f = ys[:, 0].transpose(1, 0, 2, 3)
    y_b = jnp.flip(ys[:, 1].transpose(1, 0, 2, 3), axis=1)
    y = y_f + y_b
    mean = jnp.mean(y, axis=-1, keepdims=True)
    var = jnp.mean(jnp.square(y - mean), axis=-1, keepdims=True)
    y = ((y - mean) * lax.rsqrt(var + GN_EPS)).reshape(B, T, RWKV_WIDTH) * lnx_g + lnx_b
    bonus = jnp.sum(r_h * (k_f + k_b) * r_k, axis=-1, keepdims=True) * v_h
    y = (y + bonus.reshape(B, T, RWKV_WIDTH)) * g
    return y.astype(dt)


def neighbourhood_attention_2d(q, k, v, q_gain, k_gain, rpb):
    B, T, _ = q.shape
    dt = q.dtype
    rows = T // GRID_W
    kh = min(NA_MAX_WIN_ROWS, rows)

    def qk_norm(t, g):
        t32 = t.reshape(B, T, NA_HEADS, HEAD_DIM).astype(jnp.float32)
        return t32 * lax.rsqrt(jnp.mean(t32 * t32, axis=-1, keepdims=True) + RMS_EPS) * g

    def grid(t):
        return t.reshape(B, rows, GRID_W, NA_HEADS, HEAD_DIM).transpose(0, 3, 1, 2, 4)

    qg = grid(qk_norm(q, q_gain) * (HEAD_DIM ** -0.5))
    kg = grid(qk_norm(k, k_gain))
    vg = grid(v.reshape(B, T, NA_HEADS, HEAD_DIM).astype(jnp.float32))

    cols = np.arange(GRID_W)
    col_start = np.clip(cols - NA_WIN_COLS // 2, 0, GRID_W - NA_WIN_COLS)
    col_mask = ((cols[None, :] >= col_start[:, None])
                & (cols[None, :] < col_start[:, None] + NA_WIN_COLS))
    col_off = np.clip(cols[None, :] - cols[:, None] + NA_WIN_COLS - 1, 0, 2 * NA_WIN_COLS - 2)

    def row_block(i):
        start = jnp.clip(i - kh // 2, 0, rows - kh)
        k_blk = lax.dynamic_slice_in_dim(kg, start, kh, axis=2)
        v_blk = lax.dynamic_slice_in_dim(vg, start, kh, axis=2)
        q_blk = lax.dynamic_index_in_dim(qg, i, axis=2, keepdims=False)
        s = jnp.einsum('bhqd,bhrkd->bhqrk', q_blk, k_blk)
        row_off = start + jnp.arange(kh) - i + NA_MAX_WIN_ROWS - 1
        bias = rpb.astype(jnp.float32)[:, row_off][:, :, col_off]
        s = s + bias.transpose(0, 2, 1, 3)[None]
        s = jnp.where(col_mask[:, None, :], s, NEG_INF)
        prob = jax.nn.softmax(s, axis=(-2, -1))
        return jnp.einsum('bhqrk,bhrkd->bhqd', prob, v_blk)

    out = lax.map(row_block, jnp.arange(rows))
    out = out.transpose(1, 0, 3, 2, 4).reshape(B, T, NA_WIDTH)
    return out.astype(dt)


def hierarchical_moe(h, w_rg, b_rg, w_re, b_re, w_gate_e, w_up_e, w_down_e):
    B, T, D = h.shape
    ht = h.reshape(B * T, D)
    n_tok = ht.shape[0]
    g_logits = (ht @ w_rg + b_rg).astype(jnp.float32)
    g_sel = jnp.argmax(g_logits, axis=-1)
    p_group = jnp.take_along_axis(jax.nn.softmax(g_logits, axis=-1), g_sel[:, None], axis=-1)
    e_logits = (ht @ w_re + b_re).astype(jnp.float32).reshape(n_tok, N_GROUPS, EXPERTS_PER_GROUP)
    e_in_group = jnp.take_along_axis(e_logits, g_sel[:, None, None], axis=1)[:, 0]
    top_val, top_idx = lax.top_k(e_in_group, TOP_K_IN_GROUP)
    weights = p_group * jax.nn.softmax(top_val, axis=-1)
    expert_id = g_sel[:, None] * EXPERTS_PER_GROUP + top_idx
    combine = jnp.sum(jax.nn.one_hot(expert_id, N_EXPERTS, dtype=jnp.float32) * weights[..., None], axis=1)
    combine = combine.astype(h.dtype)
    y = jnp.zeros_like(ht)
    for e in range(N_EXPERTS):
        he = jax.nn.silu(ht @ w_gate_e[e]) * (ht @ w_up_e[e])
        y = y + combine[:, e:e + 1] * (he @ w_down_e[e])
    return y.reshape(B, T, D)


def setup_inputs(seed: int = 0) -> dict:
    key = jax.random.key(seed)
    ks = iter(jax.random.split(key, 40))
    L = DEPTH

    def nrm(shape, scale):
        return jax.random.normal(next(ks), shape, jnp.float32) * scale

    def unif(shape, lo, hi):
        return jax.random.uniform(next(ks), shape, jnp.float32, lo, hi)

    return {
        'x': nrm((BATCH, SEQ, D_MODEL), 1.0),
        'norm1_g': 1.0 + nrm((L, D_MODEL), 0.02),
        'w_in': nrm((L, D_MODEL, IN_COLS), D_MODEL ** -0.5),
        'mu_prev': unif((L, RWKV_COLS), 0.0, 0.5),
        'mu_next': unif((L, RWKV_COLS), 0.0, 0.5),
        'w0_f': unif((L, RWKV_WIDTH), -6.0, 1.0),
        'w_up_f': nrm((L, DECAY_RANK, RWKV_WIDTH), DECAY_RANK ** -0.5),
        'w0_b': unif((L, RWKV_WIDTH), -6.0, 1.0),
        'w_up_b': nrm((L, DECAY_RANK, RWKV_WIDTH), DECAY_RANK ** -0.5),
        'a0_f': nrm((L, RWKV_WIDTH), 0.5),
        'a_up_f': nrm((L, ICLR_RANK, RWKV_WIDTH), ICLR_RANK ** -0.5),
        'a0_b': nrm((L, RWKV_WIDTH), 0.5),
        'a_up_b': nrm((L, ICLR_RANK, RWKV_WIDTH), ICLR_RANK ** -0.5),
        'g_up': nrm((L, GATE_RANK, RWKV_WIDTH), GATE_RANK ** -0.5),
        'k_k': 0.85 + nrm((L, RWKV_WIDTH), 0.05),
        'k_a': 1.0 + nrm((L, RWKV_WIDTH), 0.05),
        'r_k': nrm((L, RWKV_HEADS, HEAD_DIM), 0.1),
        'lnx_g': 1.0 + nrm((L, RWKV_WIDTH), 0.02),
        'lnx_b': nrm((L, RWKV_WIDTH), 0.01),
        'q_gain': 1.0 + nrm((L, HEAD_DIM), 0.02),
        'k_gain': 1.0 + nrm((L, HEAD_DIM), 0.02),
        'rpb': nrm((L, NA_HEADS, 2 * NA_MAX_WIN_ROWS - 1, 2 * NA_WIN_COLS - 1), 0.1),
        'b_gate': nrm((L, GATE_COLS), 0.01),
        'w_o_rwkv': nrm((L, RWKV_WIDTH, D_MODEL), RWKV_WIDTH ** -0.5),
        'w_o_na': nrm((L, NA_WIDTH, D_MODEL), NA_WIDTH ** -0.5),
        'w_out': nrm((L, D_MODEL, D_MODEL), D_MODEL ** -0.5),
        'norm2_g': 1.0 + nrm((L, D_MODEL), 0.02),
        'w_router_group': nrm((L, D_MODEL, N_GROUPS), D_MODEL ** -0.5),
        'b_router_group': nrm((L, N_GROUPS), 0.01),
        'w_router_expert': nrm((L, D_MODEL, N_EXPERTS), D_MODEL ** -0.5),
        'b_router_expert': nrm((L, N_EXPERTS), 0.01),
        'w_gate_e': nrm((L, N_EXPERTS, D_MODEL, D_EXPERT), D_MODEL ** -0.5),
        'w_up_e': nrm((L, N_EXPERTS, D_MODEL, D_EXPERT), D_MODEL ** -0.5),
        'w_down_e': nrm((L, N_EXPERTS, D_EXPERT, D_MODEL), D_EXPERT ** -0.5),
    }


def reference(x, norm1_g, w_in, mu_prev, mu_next, w0_f, w_up_f, w0_b, w_up_b, a0_f, a_up_f,
              a0_b, a_up_b, g_up, k_k, k_a, r_k, lnx_g, lnx_b, q_gain, k_gain, rpb, b_gate,
              w_o_rwkv, w_o_na, w_out, norm2_g, w_router_group, b_router_group,
              w_router_expert, b_router_expert, w_gate_e, w_up_e, w_down_e):
    for l in range(DEPTH):
        h = rmsnorm(x, norm1_g[l])
        p = h @ w_in[l]
        p_rwkv, q, k, v, gate_logits = jnp.split(p, IN_SPLITS, axis=-1)
        y_a = rwkv7_bidirectional(p_rwkv, mu_prev[l], mu_next[l], w0_f[l], w_up_f[l], w0_b[l],
                                  w_up_b[l], a0_f[l], a_up_f[l], a0_b[l], a_up_b[l], g_up[l],
                                  k_k[l], k_a[l], r_k[l], lnx_g[l], lnx_b[l]) @ w_o_rwkv[l]
        y_b = neighbourhood_attention_2d(q, k, v, q_gain[l], k_gain[l], rpb[l]) @ w_o_na[l]
        g_a, g_b = jnp.split(jax.nn.sigmoid(gate_logits + b_gate[l]), 2, axis=-1)
        x = x + (g_a * y_a + g_b * y_b) @ w_out[l]
        x = x + hierarchical_moe(rmsnorm(x, norm2_g[l]), w_router_group[l], b_router_group[l],
                                 w_router_expert[l], b_router_expert[l], w_gate_e[l],
                                 w_up_e[l], w_down_e[l])
    return x
```

```cpp
#include <hip/hip_runtime.h>
#include <hip/hip_cooperative_groups.h>
#include <cstdio>
#include <cstdint>
namespace cg = cooperative_groups;

#define LAS __attribute__((address_space(3)))
typedef unsigned short bf16_t;
typedef short bf16x8 __attribute__((ext_vector_type(8)));
typedef float f32x4 __attribute__((ext_vector_type(4)));
typedef unsigned u32x4 __attribute__((ext_vector_type(4)));
typedef unsigned u32x2 __attribute__((ext_vector_type(2)));

__device__ __forceinline__ float bf2f(bf16_t b) { return __uint_as_float(((unsigned)b) << 16); }
__device__ __forceinline__ bf16_t f2bf(float f) { unsigned u = __float_as_uint(f); u += 0x7FFFu + ((u >> 16) & 1u); return (bf16_t)(u >> 16); }
typedef __bf16 bf16x2_t __attribute__((ext_vector_type(2)));
typedef float f32x2 __attribute__((ext_vector_type(2)));
__device__ __forceinline__ unsigned cvt_pk_bf16(float lo, float hi) { const f32x2 v = {lo, hi}; return __builtin_bit_cast(unsigned, __builtin_convertvector(v, bf16x2_t)); }
typedef short s16x4 __attribute__((ext_vector_type(4)));
__device__ __forceinline__ void unpack8f(const u32x4 w, float (&f)[8]) {
  f[0] = __uint_as_float(w.x << 16); f[1] = __uint_as_float(w.x & 0xffff0000u); f[2] = __uint_as_float(w.y << 16); f[3] = __uint_as_float(w.y & 0xffff0000u);
  f[4] = __uint_as_float(w.z << 16); f[5] = __uint_as_float(w.z & 0xffff0000u); f[6] = __uint_as_float(w.w << 16); f[7] = __uint_as_float(w.w & 0xffff0000u);
}
struct GB { __amdgpu_buffer_rsrc_t r; const char* base; };
__device__ __forceinline__ GB mkgb(const void* base, unsigned bytes) { GB g; g.r = __builtin_amdgcn_make_buffer_rsrc((void*)base, 0, bytes, 0x00020000); g.base = (const char*)base; return g; }
__device__ __forceinline__ u32x4 ld16(const GB& g, const void* p) { return __builtin_amdgcn_raw_buffer_load_b128(g.r, (int)((const char*)p - g.base), 0, 16); }
__device__ __forceinline__ f32x4 ld16f(const GB& g, const void* p) { return __builtin_bit_cast(f32x4, ld16(g, p)); }
__device__ __forceinline__ u32x2 ld8(const GB& g, const void* p) { return __builtin_amdgcn_raw_buffer_load_b64(g.r, (int)((const char*)p - g.base), 0, 16); }
__device__ __forceinline__ float ld4f(const GB& g, const float* p) { return __uint_as_float(__builtin_amdgcn_raw_buffer_load_b32(g.r, (int)((const char*)p - g.base), 0, 16)); }
__device__ __forceinline__ int ld4i(const GB& g, const int* p) { return (int)__builtin_amdgcn_raw_buffer_load_b32(g.r, (int)((const char*)p - g.base), 0, 16); }
#define GB_WS(P) mkgb((P).ws, 0x20000000u)
#define GB_OUT(P) mkgb((P).out, 0x08000000u)
__device__ __forceinline__ float sigmoidf_(float x) { return __builtin_amdgcn_rcpf(1.f + __expf(-x)); }
template <int CTRL> __device__ __forceinline__ float dpp_f(float x) { return __builtin_bit_cast(float, __builtin_amdgcn_update_dpp(0, __builtin_bit_cast(int, x), CTRL, 0xF, 0xF, true)); }
__device__ __forceinline__ float sum4(float x) { x += dpp_f<0xB1>(x); x += dpp_f<0x4E>(x); return x; }
__device__ __forceinline__ float sum8(float x) { x = sum4(x); x += dpp_f<0x141>(x); return x; }
__device__ __forceinline__ float sum16(float x) { x = sum8(x); x += dpp_f<0x140>(x); return x; }
__device__ __forceinline__ float sum16x4(const float (&x)[4], int fr) {
  const bool o1 = (fr & 1) != 0, o2 = (fr & 2) != 0;
  const float s01 = (o1 ? x[1] : x[0]) + dpp_f<0xB1>(o1 ? x[0] : x[1]);
  const float s23 = (o1 ? x[3] : x[2]) + dpp_f<0xB1>(o1 ? x[2] : x[3]);
  float t = (o2 ? s23 : s01) + dpp_f<0x4E>(o2 ? s01 : s23);
  t += dpp_f<0x124>(t); t += dpp_f<0x128>(t);
  return t;
}
__device__ __forceinline__ s16x4 lds_tr16(LAS unsigned char* lds, int byte_off) { return __builtin_amdgcn_ds_read_tr16_b64_v4i16((LAS s16x4*)(lds + byte_off)); }
__device__ __forceinline__ float wave_sum(float v) { v = sum16(v); v += __shfl_xor(v, 16); v += __shfl_xor(v, 32); return v; }
__device__ __forceinline__ float wave_max(float v) {
#pragma unroll
  for (int o = 32; o > 0; o >>= 1) v = fmaxf(v, __shfl_xor(v, o));
  return v;
}

constexpr int NB = 16, T = 2048, D = 1024, NTOK = NB * T;
constexpr int INC = 5504, INCP = 5632, C_R = 0, C_K = 512, C_V = 1024, C_WL = 1536, C_AL = 1664, C_GL = 1792, C_Q = 1920, C_NK = 2432, C_NV = 2944, C_G = 3456;
constexpr int NTHR = 512;
constexpr int MAXRT = 320;
constexpr size_t MiB = 1024 * 1024;
constexpr size_t WS_P = 0;
constexpr size_t WS_G8 = 216 * MiB;
constexpr size_t WS_H = 344 * MiB;
constexpr size_t WS_RY = WS_H;
constexpr size_t WS_NY = WS_H + 1024;
constexpr size_t WS_SD = 408 * MiB;
constexpr size_t WS_MIX = 410 * MiB;
constexpr size_t WS_VBLK = WS_MIX;
constexpr size_t WS_GUPT = 493 * MiB;
constexpr size_t WS_EID = 474 * MiB;
constexpr size_t WS_EW = WS_EID + 256 * 1024;
constexpr size_t WS_RANK = WS_EW + 256 * 1024;
constexpr size_t WS_CNT = WS_RANK + 256 * 1024;
constexpr size_t WS_BAR = WS_CNT + 4096;
constexpr size_t WS_RSG = WS_CNT + 65536;
constexpr size_t WS_TOKS = 476 * MiB;
constexpr size_t WS_WTS = WS_TOKS + 512 * 1024;
constexpr size_t WS_RSS = WS_TOKS + 1024 * 1024;
constexpr size_t WS_W1T = 478 * MiB;
constexpr size_t WS_WOA = 489 * MiB;
constexpr size_t WS_WOB = 490 * MiB;
constexpr size_t WS_WOUT = 491 * MiB;
constexpr size_t WS_WR = 493 * MiB + 512 * 1024;
constexpr size_t WS_NEED = 494 * MiB;
constexpr size_t WS_DELTA = 0;
constexpr size_t WS_LTOK = 64 * MiB;
constexpr size_t WS_LW = 72 * MiB;
constexpr size_t WS_LRS = 80 * MiB;
constexpr size_t WS_HE = 328 * MiB;
constexpr size_t WS_WGU = 280 * MiB;
constexpr size_t WS_WD = 312 * MiB;
constexpr size_t WS_O = 88 * MiB;

struct Params { const float* in[34]; float* out; unsigned char* ws; };

#define XB_TMO      128
#define XB_XCNT(j)  (256  + 64 * (j))
#define XB_XSUB(j)  (1280 + 64 * (j))
#define XB_XGEN(j)  (2304 + 64 * (j))
#define XB_TOP      3328
#define XB_TOPGEN   3392
#define XCD_BAR_WORDS 3456
#define XB_SPIN_CAP (1u << 22)
__device__ __forceinline__ unsigned xb_ld(unsigned* p)              { return __hip_atomic_load(p, __ATOMIC_RELAXED, __HIP_MEMORY_SCOPE_AGENT); }
__device__ __forceinline__ unsigned xb_add(unsigned* p, unsigned v) { return __hip_atomic_fetch_add(p, v, __ATOMIC_RELAXED, __HIP_MEMORY_SCOPE_AGENT); }
__device__ __forceinline__ unsigned xb_xcc_id() { return (unsigned)__builtin_amdgcn_s_getreg((3 << 11) | 20) & 0xFu; }
#define XB_SPIN(cond, bar) do { unsigned _sp = 0; while (cond) { __builtin_amdgcn_s_sleep(1); \
    if ((++_sp & 255u) == 0u) { if (xb_ld(&(bar)[XB_TMO])) break; if (_sp > XB_SPIN_CAP) { atomicAdd(&(bar)[XB_TMO], 1u); break; } } } } while (0)
struct XcdBarrier { unsigned* bar; unsigned x; volatile LAS unsigned* st; };
__device__ __forceinline__ XcdBarrier xcd_barrier_post(unsigned* bar, volatile LAS unsigned* st) {
  XcdBarrier b; b.bar = bar; b.x = xb_xcc_id(); b.st = st;
  if (threadIdx.x == 0) (void)xb_add(&bar[XB_XCNT(b.x)], 1u);
  return b;
}
__device__ __forceinline__ void xcd_barrier_complete(unsigned* bar, unsigned x, unsigned& nloc, unsigned& nx) {
  const unsigned G = gridDim.x * gridDim.y * gridDim.z;
  unsigned sum, cnt, mine, sp = 0u;
  for (;;) {
    sum = 0u; cnt = 0u; mine = 0u;
#pragma unroll
    for (unsigned j = 0; j < 16; ++j) { const unsigned c = xb_ld(&bar[XB_XCNT(j)]); sum += c; cnt += (c > 0u) ? 1u : 0u; mine = (j == x) ? c : mine; }
    if (sum == G) break;
    __builtin_amdgcn_s_sleep(1);
    if ((++sp & 255u) == 0u) { if (xb_ld(&bar[XB_TMO])) break; if (sp > XB_SPIN_CAP) { atomicAdd(&bar[XB_TMO], 1u); break; } }
  }
  nloc = mine > 0u ? mine : 1u; nx = cnt > 0u ? cnt : 1u;
}
__device__ __forceinline__ void xcd_barrier(const XcdBarrier& b) {
  asm volatile("s_waitcnt vmcnt(0)" ::: "memory");
  __syncthreads();
  if (threadIdx.x == 0) {
    unsigned* bar = b.bar; const unsigned bx_ = xb_xcc_id();
    __builtin_amdgcn_s_waitcnt(0);
    unsigned nloc = b.st[0], nx = b.st[1];
    if (nloc == 0u) { xcd_barrier_complete(bar, bx_, nloc, nx); b.st[0] = nloc; b.st[1] = nx; }
    const unsigned old = xb_add(&bar[XB_XSUB(bx_)], 1u);
    const unsigned gen = old / nloc;
    if (old + 1u == (gen + 1u) * nloc) {
      __builtin_amdgcn_fence(__ATOMIC_RELEASE, "agent");
      asm volatile("s_waitcnt vmcnt(0)" ::: "memory");
      const unsigned og = xb_add(&bar[XB_TOP], 1u);
      const unsigned tg = og / nx;
      if (og + 1u == (tg + 1u) * nx) xb_add(&bar[XB_TOPGEN], 1u);
      else XB_SPIN(xb_ld(&bar[XB_TOPGEN]) == tg, bar);
      __builtin_amdgcn_fence(__ATOMIC_ACQUIRE, "agent");
      xb_add(&bar[XB_XGEN(bx_)], 1u);
      asm volatile("s_waitcnt vmcnt(0)" ::: "memory");
    } else {
      XB_SPIN(xb_ld(&bar[XB_XGEN(bx_)]) == gen, bar);
      __builtin_amdgcn_fence(__ATOMIC_ACQUIRE, "agent");
      asm volatile("s_waitcnt vmcnt(0)" ::: "memory");
    }
  }
  __syncthreads();
}

namespace pg8 {
#define PG8_AUX_A 16
#define PG8_AUX_B 16
constexpr int BM = 256, BK = 64, HALF = 128, HTB = HALF * BK * 2, STAGE_BYTES = 8 * HTB, NXCD = 8, WGM = 8;
__host__ __device__ __forceinline__ int lds_byte(int r, int c) { const int st = (r >> 4) * 2 + (c >> 5), rr = r & 15, cc = c & 31, ob = rr * 64 + cc * 2; return st * 1024 + (ob ^ (((ob >> 9) & 1) << 5)); }
__host__ __device__ __forceinline__ void stage_rc(int b, int& R, int& C) { const int st = b / 1024, sb = b % 1024, swz = sb ^ (((sb >> 9) & 1) << 5); R = (st >> 1) * 16 + swz / 64; C = (st & 1) * 32 + (swz % 64) / 2; }
__host__ __device__ __forceinline__ int perm32(int rho) { const int n = rho >> 4, i = rho & 15; return 8 * (i >> 2) + 4 * n + (i & 3); }

struct Unit { int pm, pn, l, r0; };
struct Gemm { const bf16_t* A; const bf16_t* Bt; int K; };

struct StaticOrder {
  int nM, nN, nwg, G, c;
  __device__ void init(int M, int N, int G_, int c_) { nM = M / BM; nN = N / BM; nwg = nM * nN; G = G_; c = c_; }
  __device__ bool next(int i, Unit& u) const {
    const long L = (long)i * G + c; if (L >= nwg) return false;
    int wgid = (int)L; { const int q = nwg / NXCD, r = nwg % NXCD, xcd = wgid % NXCD, off = wgid / NXCD; wgid = (xcd < r ? xcd * (q + 1) : r * (q + 1) + (xcd - r) * q) + off; }
    const int nig = WGM * nN, gid = wgid / nig, fm = gid * WGM, gsz = (nM - fm) < WGM ? (nM - fm) : WGM;
    u.pm = fm + ((wgid % nig) % gsz); u.pn = (wgid % nig) / gsz; u.l = 0; u.r0 = 0; return true;
  }
};
struct MoeOrder {
  const LAS int* rtoff;
  int rt0, nrt, nct, G, v;
  __device__ bool next(int i, Unit& u) const {
    const int L = i * G + v; if (L >= nrt * nct) return false;
    const int rt = rt0 + L / nct, ct = L % nct;
    const int l = rtoff[136 + rt];
    u.pm = rt; u.pn = (l & 31) * nct + ct; u.l = l; u.r0 = (rt - rtoff[l]) * 256; return true;
  }
  const int* ltok;
  GB gw;
  __device__ __forceinline__ int a_row(const Unit& u, int r) const { const int rr = u.r0 + r; return rr < rtoff[65 + u.l] ? ld4i(gw, ltok + (size_t)u.l * NTOK + rr) : 0; }
};

template <bool GATHER = false, class Epi, class Sched>
__device__ __forceinline__ void gemm_phase(LAS unsigned char* lds, const Gemm g, const Sched& S, const Epi& E) {
  int tid_ = threadIdx.x; asm volatile("" : "+v"(tid_));
  const int tid = tid_, wid = __builtin_amdgcn_readfirstlane(tid >> 6), lane = tid & 63, wr = wid >> 2, wc = wid & 3, fr = lane & 15, fq = lane >> 4;
  const int K = g.K, nt = K / BK;
  unsigned voffA[2], voffB[2];
#pragma unroll
  for (int i = 0; i < 2; ++i) { int R, C; stage_rc(tid * 16 + i * 8192, R, C); const int Rb = Epi::PERM ? ((R & ~31) + perm32(R & 31)) : R;
    voffA[i] = (unsigned)(R * K + C) * 2u; voffB[i] = (unsigned)(Rb * K + C) * 2u; }
  unsigned vAc[2][2], vAn[2][2];
#define PG8_AROWS(dst, u) do { if constexpr (GATHER) { int _t = threadIdx.x; asm volatile("" : "+v"(_t)); _Pragma("unroll") for (int _i = 0; _i < 2; ++_i) { int _R, _C; stage_rc(_t * 16 + _i * 8192, _R, _C); \
    _Pragma("unroll") for (int _h = 0; _h < 2; ++_h) dst[_h][_i] = ((unsigned)S.a_row(u, _h * HALF + _R) * (unsigned)K + (unsigned)_C) * 2u; } } } while (0)
  const size_t kstep = (size_t)(BK * 2);
  const size_t hstep = (size_t)HALF * K * 2;
  const size_t tstep = 2 * hstep;
  const unsigned ldsw = (unsigned)wid * 1024u;
  const int aoff = lds_byte(wr * 64 + fr, fq * 8), boff = lds_byte(wc * 32 + fr, fq * 8);
#define PG8_SA(b, h) (((b) * 2 + (h)) * HTB)
#define PG8_SB(b, h) ((4 + (b) * 2 + (h)) * HTB)
#define PG8_STAGE_X(bufoff, gbase, voff, AUX) do { _Pragma("unroll") for (int _i = 0; _i < 2; ++_i) \
    __builtin_amdgcn_global_load_lds((const unsigned*)((const char*)(gbase) + (voff)[_i]), (LAS unsigned*)(lds + (bufoff) + ldsw + _i * 8192), 16, 0, AUX); } while (0)
#define PG8_STAGE(bufoff, gbase, voff) PG8_STAGE_X(bufoff, gbase, voff, PG8_AUX_B)
#define PG8_STAGE_A(bufoff, gbase, h, nx) do { if constexpr (GATHER) { _Pragma("unroll") for (int _i = 0; _i < 2; ++_i) \
      __builtin_amdgcn_global_load_lds((const unsigned*)((const char*)(gbase) + ((nx) ? vAn[h][_i] : vAc[h][_i])), (LAS unsigned*)(lds + (bufoff) + ldsw + _i * 8192), 16, 0, PG8_AUX_A); } \
    else { PG8_STAGE_X(bufoff, (const char*)(gbase) + ((h) ? hstep : 0), voffA, PG8_AUX_A); } } while (0)
#define PG8_LDA(dst, b, h) do { _Pragma("unroll") for (int m = 0; m < 4; ++m) _Pragma("unroll") for (int k = 0; k < 2; ++k) dst[m][k] = *(const LAS bf16x8*)(lds + PG8_SA(b, h) + aoff + m * 2048 + k * 1024); } while (0)
#define PG8_LDB(dst, b, h) do { _Pragma("unroll") for (int n = 0; n < 2; ++n) _Pragma("unroll") for (int k = 0; k < 2; ++k) dst[n][k] = *(const LAS bf16x8*)(lds + PG8_SB(b, h) + boff + n * 2048 + k * 1024); } while (0)
#define PG8_MMA(ai, bj, At, Bt) do { __builtin_amdgcn_s_setprio(1); _Pragma("unroll") for (int m = 0; m < 4; ++m) _Pragma("unroll") for (int n = 0; n < 2; ++n) _Pragma("unroll") for (int k = 0; k < 2; ++k) \
    acc[ai][bj][m][n] = __builtin_amdgcn_mfma_f32_16x16x32_bf16(Bt[n][k], At[m][k], acc[ai][bj][m][n], 0, 0, 0); __builtin_amdgcn_s_setprio(0); } while (0)
#define PG8_WAIT_V(n) asm volatile("s_waitcnt vmcnt(" #n ")" ::: "memory")
#define PG8_WAIT_L(n) asm volatile("s_waitcnt lgkmcnt(" #n ")" ::: "memory")
#define PG8_BAR __builtin_amdgcn_s_barrier()
#define PG8_SCHED __builtin_amdgcn_sched_barrier(0)
  Unit cur, nxt; int ui = 0;
  if (!S.next(0, cur)) return;
  f32x4 acc[2][2][4][2];
#pragma unroll
  for (int a = 0; a < 2; ++a)
#pragma unroll
    for (int b = 0; b < 2; ++b)
#pragma unroll
      for (int m = 0; m < 4; ++m)
#pragma unroll
        for (int n = 0; n < 2; ++n) acc[a][b][m][n] = (f32x4){0.f, 0.f, 0.f, 0.f};
  bf16x8 At[4][2], B0[2][2], B1[2][2];
  const char* cA = (const char*)g.A + (GATHER ? (size_t)0 : (size_t)cur.pm * tstep); const char* cB = (const char*)g.Bt + (size_t)cur.pn * tstep;
  PG8_AROWS(vAc, cur);
#pragma unroll
  for (int _h = 0; _h < 2; ++_h)
#pragma unroll
    for (int _i = 0; _i < 2; ++_i) vAn[_h][_i] = vAc[_h][_i];
  PG8_STAGE(PG8_SB(0, 0), cB, voffB); PG8_STAGE_A(PG8_SA(0, 0), cA, 0, false); PG8_STAGE(PG8_SB(0, 1), cB + hstep, voffB); PG8_STAGE_A(PG8_SA(0, 1), cA, 1, false);
  if (wr == 1) PG8_BAR;
  PG8_WAIT_V(4); PG8_BAR;
  PG8_STAGE(PG8_SB(1, 0), cB + kstep, voffB); PG8_STAGE_A(PG8_SA(1, 0), cA + kstep, 0, false); PG8_STAGE(PG8_SB(1, 1), cB + hstep + kstep, voffB);
  PG8_WAIT_V(6); PG8_BAR;
  for (;;) {
    const bool has_next = S.next(ui + 1, nxt);
    const char* nA = has_next ? (const char*)g.A + (GATHER ? (size_t)0 : (size_t)nxt.pm * tstep) : cA; const char* nB = has_next ? (const char*)g.Bt + (size_t)nxt.pn * tstep : cB;
    if (has_next) PG8_AROWS(vAn, nxt);
    float pre[8];
    if constexpr (Epi::PRE) { int fr_ = fr; asm volatile("" : "+v"(fr_)); E.preload(cur, wr, fr_, pre); }
    for (int t = 0; t < nt; t += 2) {
      if constexpr (Epi::MID) { int mid_ = __builtin_amdgcn_readfirstlane(2 * t == nt); asm volatile("" : "+s"(mid_));
        if (mid_) { int fr_ = fr, fq_ = fq; asm volatile("" : "+v"(fr_), "+v"(fq_)); E.mid(acc, cur, wr, wc, fr_, fq_); } }
      const bool last = (t == nt - 2);
      const char* a1 = cA + (size_t)(t + 1) * kstep;
      const char* a2 = last ? nA : cA + (size_t)(t + 2) * kstep; const char* b2 = last ? nB : cB + (size_t)(t + 2) * kstep;
      const char* a3 = a2 + kstep; const char* b3 = b2 + kstep;
      PG8_LDB(B0, 0, 0); PG8_SCHED; PG8_LDA(At, 0, 0); PG8_STAGE_A(PG8_SA(1, 1), a1, 1, false);
      PG8_WAIT_L(8); PG8_BAR; PG8_WAIT_L(0); PG8_MMA(0, 0, At, B0); PG8_BAR; PG8_SCHED;
      PG8_LDB(B1, 0, 1); PG8_STAGE(PG8_SB(0, 0), b2, voffB);
      PG8_BAR; PG8_WAIT_L(0); PG8_MMA(0, 1, At, B1); PG8_BAR;
      PG8_LDA(At, 0, 1); PG8_STAGE_A(PG8_SA(0, 0), a2, 0, last);
      PG8_BAR; PG8_WAIT_L(0); PG8_MMA(1, 0, At, B0); PG8_BAR; PG8_SCHED;
      PG8_STAGE(PG8_SB(0, 1), b2 + hstep, voffB);
      PG8_WAIT_V(6); PG8_BAR; PG8_MMA(1, 1, At, B1); PG8_BAR;
      PG8_LDB(B0, 1, 0); PG8_SCHED; PG8_LDA(At, 1, 0); PG8_STAGE_A(PG8_SA(0, 1), a2, 1, last);
      PG8_WAIT_L(8); PG8_BAR; PG8_WAIT_L(0); PG8_MMA(0, 0, At, B0); PG8_BAR; PG8_SCHED;
      PG8_LDB(B1, 1, 1); PG8_STAGE(PG8_SB(1, 0), b3, voffB);
      PG8_BAR; PG8_WAIT_L(0); PG8_MMA(0, 1, At, B1); PG8_BAR;
      PG8_LDA(At, 1, 1); PG8_STAGE_A(PG8_SA(1, 0), a3, 0, last);
      PG8_BAR; PG8_WAIT_L(0); PG8_MMA(1, 0, At, B0); PG8_BAR; PG8_SCHED;
      PG8_STAGE(PG8_SB(1, 1), b3 + hstep, voffB);
      PG8_WAIT_V(6); PG8_BAR; PG8_MMA(1, 1, At, B1); PG8_BAR;
    }
    { int fr_ = fr, fq_ = fq; asm volatile("" : "+v"(fr_), "+v"(fq_));
      if constexpr (Epi::PRE) E(acc, cur, wr, wc, fr_, fq_, pre); else E(acc, cur, wr, wc, fr_, fq_); }
    if (!has_next) break;
#pragma unroll
    for (int a = 0; a < 2; ++a)
#pragma unroll
      for (int b = 0; b < 2; ++b)
#pragma unroll
        for (int m = 0; m < 4; ++m)
#pragma unroll
          for (int n = 0; n < 2; ++n) acc[a][b][m][n] = (f32x4){0.f, 0.f, 0.f, 0.f};
    cur = nxt; cA = nA; cB = nB; ++ui;
#pragma unroll
    for (int _h = 0; _h < 2; ++_h)
#pragma unroll
      for (int _i = 0; _i < 2; ++_i) vAc[_h][_i] = vAn[_h][_i];
  }
  PG8_WAIT_V(0);
  if (wr == 0) PG8_BAR;
  PG8_BAR;
#undef PG8_SA
#undef PG8_SB
#undef PG8_STAGE
#undef PG8_STAGE_X
#undef PG8_STAGE_A
#undef PG8_AROWS
#undef PG8_LDA
#undef PG8_LDB
#undef PG8_MMA
#undef PG8_WAIT_V
#undef PG8_WAIT_L
#undef PG8_BAR
#undef PG8_SCHED
}
}
using pg8::Unit;

__device__ __forceinline__ unsigned ptok(int tok) { return (unsigned)(tok >> 8) * (27u * 32768u) + (unsigned)((tok & 255) >> 4) * 2048u + (unsigned)(tok & 15) * 8u; }
__device__ __forceinline__ unsigned pcol(int col) { return (unsigned)(col >> 7) * 32768u + (unsigned)((col >> 5) & 3) * 512u + (unsigned)((col >> 3) & 3) * 128u + (unsigned)(col & 7); }
__device__ __forceinline__ unsigned gtok(int tok) { return (unsigned)(tok >> 8) * (16u * 32768u) + (unsigned)((tok & 255) >> 4) * 2048u + (unsigned)(tok & 15) * 8u; }
__device__ __forceinline__ unsigned gcol(int gc) { return (unsigned)(gc >> 7) * 32768u + (unsigned)((gc >> 5) & 3) * 512u + (unsigned)((gc >> 3) & 3) * 128u + (unsigned)(gc & 7); }
struct EpiP {
  static constexpr bool PERM = true; static constexpr bool MID = false; static constexpr bool PRE = false;
  bf16_t* Pm; const float* b_gate; unsigned char* G8;
  __device__ __forceinline__ void operator()(const f32x4 (&acc)[2][2][4][2], const Unit& u, int wr, int wc, int fr, int fq) const {
#pragma unroll
    for (int bj = 0; bj < 2; ++bj) {
      const int col = u.pn * 256 + bj * 128 + wc * 32 + 8 * fq;
      if (col >= INC) continue;
      const unsigned lo = (unsigned)((wr * 16 + wc) * 512 + (fq * 16 + fr) * 8);
      if (col < C_G) {
        bf16_t* tb = Pm + ((size_t)(u.pm * 27 + 2 * u.pn + bj) * 32768 + lo);
#pragma unroll
        for (int ai = 0; ai < 2; ++ai)
#pragma unroll
          for (int m = 0; m < 4; ++m) {
            const f32x4 v0 = acc[ai][bj][m][0], v1 = acc[ai][bj][m][1];
            u32x4 w; w.x = cvt_pk_bf16(v0[0], v0[1]); w.y = cvt_pk_bf16(v0[2], v0[3]); w.z = cvt_pk_bf16(v1[0], v1[1]); w.w = cvt_pk_bf16(v1[2], v1[3]);
            *(u32x4*)(tb + (ai * 32 + m * 4) * 512) = w;
          }
      } else {
        const f32x4 b0 = *(const f32x4*)(b_gate + col - C_G), b1 = *(const f32x4*)(b_gate + col - C_G + 4);
        unsigned char* gb = G8 + ((size_t)(u.pm * 16 + ((col - C_G) >> 7)) * 32768 + lo);
#pragma unroll
        for (int ai = 0; ai < 2; ++ai)
#pragma unroll
          for (int m = 0; m < 4; ++m) {
            const f32x4 v0 = acc[ai][bj][m][0], v1 = acc[ai][bj][m][1];
            unsigned q[8];
#pragma unroll
            for (int j = 0; j < 4; ++j) { q[j] = (unsigned)(sigmoidf_(v0[j] + b0[j]) * 255.f + 0.5f); q[4 + j] = (unsigned)(sigmoidf_(v1[j] + b1[j]) * 255.f + 0.5f); }
            u32x2 w; w.x = q[0] | (q[1] << 8) | (q[2] << 16) | (q[3] << 24); w.y = q[4] | (q[5] << 8) | (q[6] << 16) | (q[7] << 24);
            *(u32x2*)(gb + (ai * 32 + m * 4) * 512) = w;
          }
      }
    }
  }
};
__device__ __forceinline__ void unpack8q(const u32x2 w, float (&f)[8]) {
  f[0] = (float)(w.x & 255u); f[1] = (float)((w.x >> 8) & 255u); f[2] = (float)((w.x >> 16) & 255u); f[3] = (float)(w.x >> 24);
  f[4] = (float)(w.y & 255u); f[5] = (float)((w.y >> 8) & 255u); f[6] = (float)((w.y >> 16) & 255u); f[7] = (float)(w.y >> 24);
}
struct EpiMix {
  static constexpr bool PERM = true; static constexpr bool MID = true; static constexpr bool PRE = false;
  const unsigned char* G8; bf16_t* MIX; GB gw;
  __device__ __forceinline__ void mid(f32x4 (&acc)[2][2][4][2], const Unit& u, int wr, int wc, int fr, int fq) const {
    const int row0 = u.pm * 256 + wr * 64 + fr, col0 = u.pn * 256 + wc * 32 + 8 * fq;
#pragma unroll
    for (int ai = 0; ai < 2; ++ai) {
      u32x2 ga[4][2], gb[4][2];
#pragma unroll
      for (int m = 0; m < 4; ++m)
#pragma unroll
        for (int bj = 0; bj < 2; ++bj) { const unsigned char* gp = G8 + gtok(row0 + ai * 128 + m * 16);
          ga[m][bj] = ld8(gw, gp + gcol(col0 + bj * 128)); gb[m][bj] = ld8(gw, gp + gcol(D + col0 + bj * 128)); }
#pragma unroll
      for (int m = 0; m < 4; ++m)
#pragma unroll
        for (int bj = 0; bj < 2; ++bj) {
          float a[8], b[8]; unpack8q(ga[m][bj], a); unpack8q(gb[m][bj], b);
          f32x4 r0, r1;
#pragma unroll
          for (int j = 0; j < 4; ++j) { r0[j] = a[j] * __builtin_amdgcn_rcpf(fmaxf(b[j], 1e-6f)); r1[j] = a[4 + j] * __builtin_amdgcn_rcpf(fmaxf(b[4 + j], 1e-6f)); }
          acc[ai][bj][m][0] *= r0; acc[ai][bj][m][1] *= r1;
        }
    }
  }
  __device__ __forceinline__ void operator()(const f32x4 (&acc)[2][2][4][2], const Unit& u, int wr, int wc, int fr, int fq) const {
    const int row0 = u.pm * 256 + wr * 64 + fr, col0 = u.pn * 256 + wc * 32 + 8 * fq;
#pragma unroll
    for (int ai = 0; ai < 2; ++ai) {
      u32x2 gb[4][2];
#pragma unroll
      for (int m = 0; m < 4; ++m)
#pragma unroll
        for (int bj = 0; bj < 2; ++bj) gb[m][bj] = ld8(gw, G8 + gtok(row0 + ai * 128 + m * 16) + gcol(D + col0 + bj * 128));
#pragma unroll
      for (int m = 0; m < 4; ++m)
#pragma unroll
        for (int bj = 0; bj < 2; ++bj) {
          float b[8]; unpack8q(gb[m][bj], b);
#pragma unroll
          for (int j = 0; j < 8; ++j) b[j] = fmaxf(b[j], 1e-6f) * (1.f / 255.f);
          const f32x4 v0 = acc[ai][bj][m][0], v1 = acc[ai][bj][m][1];
          u32x4 w; w.x = cvt_pk_bf16(b[0] * v0[0], b[1] * v0[1]); w.y = cvt_pk_bf16(b[2] * v0[2], b[3] * v0[3]); w.z = cvt_pk_bf16(b[4] * v1[0], b[5] * v1[1]); w.w = cvt_pk_bf16(b[6] * v1[2], b[7] * v1[3]);
          *(u32x4*)(MIX + (size_t)(row0 + ai * 128 + m * 16) * D + col0 + bj * 128) = w;
        }
    }
  }
};
struct EpiXout {
  static constexpr bool PERM = true; static constexpr bool MID = false; static constexpr bool PRE = false;
  bf16_t* DL;
  __device__ __forceinline__ void operator()(const f32x4 (&acc)[2][2][4][2], const Unit& u, int wr, int wc, int fr, int fq) const {
    const int row0 = u.pm * 256 + wr * 64 + fr, col0 = u.pn * 256 + wc * 32 + 8 * fq;
#pragma unroll
    for (int ai = 0; ai < 2; ++ai)
#pragma unroll
      for (int m = 0; m < 4; ++m)
#pragma unroll
        for (int bj = 0; bj < 2; ++bj) { const f32x4 v0 = acc[ai][bj][m][0], v1 = acc[ai][bj][m][1];
          u32x4 w; w.x = cvt_pk_bf16(v0[0], v0[1]); w.y = cvt_pk_bf16(v0[2], v0[3]); w.z = cvt_pk_bf16(v1[0], v1[1]); w.w = cvt_pk_bf16(v1[2], v1[3]);
          *(u32x4*)(DL + (size_t)(row0 + ai * 128 + m * 16) * D + col0 + bj * 128) = w; }
  }
};
struct EpiGateUp {
  static constexpr bool PERM = true; static constexpr bool MID = false; static constexpr bool PRE = true;
  bf16_t* HE; const float* LRS; GB gw;
  __device__ __forceinline__ void preload(const Unit& u, int wr, int fr, float (&pre)[8]) const {
#pragma unroll
    for (int ai = 0; ai < 2; ++ai)
#pragma unroll
      for (int m = 0; m < 4; ++m) pre[ai * 4 + m] = ld4f(gw, LRS + (size_t)u.l * NTOK + u.r0 + wr * 64 + fr + ai * 128 + m * 16);
  }
  __device__ __forceinline__ void operator()(const f32x4 (&acc)[2][2][4][2], const Unit& u, int wr, int wc, int fr, int fq, const float (&pre)[8]) const {
    const int row0 = u.pm * 256 + wr * 64 + fr, col = (u.pn & 1) * 128 + wc * 32 + 8 * fq;
#pragma unroll
    for (int ai = 0; ai < 2; ++ai)
#pragma unroll
      for (int m = 0; m < 4; ++m) {
        const int row = row0 + ai * 128 + m * 16; const float rs = pre[ai * 4 + m];
        const f32x4 g0 = acc[ai][0][m][0] * rs, g1 = acc[ai][0][m][1] * rs, u0 = acc[ai][1][m][0] * rs, u1 = acc[ai][1][m][1] * rs;
        f32x4 o0, o1;
#pragma unroll
        for (int j = 0; j < 4; ++j) { o0[j] = g0[j] * sigmoidf_(g0[j]) * u0[j]; o1[j] = g1[j] * sigmoidf_(g1[j]) * u1[j]; }
        u32x4 w; w.x = cvt_pk_bf16(o0[0], o0[1]); w.y = cvt_pk_bf16(o0[2], o0[3]); w.z = cvt_pk_bf16(o1[0], o1[1]); w.w = cvt_pk_bf16(o1[2], o1[3]);
        *(u32x4*)(HE + (size_t)row * 256 + col) = w;
      }
  }
};
struct EpiDown {
  static constexpr bool PERM = true; static constexpr bool MID = false; static constexpr bool PRE = true;
  const float* LW; bf16_t* O; GB gw;
  __device__ __forceinline__ void preload(const Unit& u, int wr, int fr, float (&pre)[8]) const {
#pragma unroll
    for (int ai = 0; ai < 2; ++ai)
#pragma unroll
      for (int m = 0; m < 4; ++m) pre[ai * 4 + m] = ld4f(gw, LW + (size_t)u.l * NTOK + u.r0 + wr * 64 + fr + ai * 128 + m * 16);
  }
  __device__ __forceinline__ void operator()(const f32x4 (&acc)[2][2][4][2], const Unit& u, int wr, int wc, int fr, int fq, const float (&pre)[8]) const {
    const int row0 = u.pm * 256 + wr * 64 + fr, colb = (u.pn & 3) * 256 + wc * 32 + 8 * fq;
#pragma unroll
    for (int ai = 0; ai < 2; ++ai)
#pragma unroll
      for (int m = 0; m < 4; ++m) {
        bf16_t* op = O + (size_t)(row0 + ai * 128 + m * 16) * D + colb; const float ww = pre[ai * 4 + m];
#pragma unroll
        for (int bj = 0; bj < 2; ++bj) { const f32x4 v0 = acc[ai][bj][m][0] * ww, v1 = acc[ai][bj][m][1] * ww;
          u32x4 pk; pk.x = cvt_pk_bf16(v0[0], v0[1]); pk.y = cvt_pk_bf16(v0[2], v0[3]); pk.z = cvt_pk_bf16(v1[0], v1[1]); pk.w = cvt_pk_bf16(v1[2], v1[3]);
          *(u32x4*)(op + bj * 128) = pk; }
      }
  }
};

struct TDesc { const float* W; bf16_t* Wt; int ldw, k0, n0, K, drow0; };
template <class DescOf>
__device__ __forceinline__ void transpose_items(int first, int count, int stride, const DescOf& desc_of, float* sm) {
  int tid_ = threadIdx.x; asm volatile("" : "+v"(tid_)); const int tid = tid_;
  float r[8], rn[8]; TDesc d{}, dn{};
#define TT_LOAD(DD, RR) do { _Pragma("unroll") for (int i_ = 0; i_ < 8; ++i_) { const int e_ = tid + i_ * NTHR; RR[i_] = __builtin_nontemporal_load(DD.W + (size_t)(DD.k0 + (e_ >> 6)) * DD.ldw + DD.n0 + (e_ & 63)); } } while (0)
  int it = first;
  if (it < count) { d = desc_of(it); TT_LOAD(d, r); }
  for (; it < count; it += stride) {
    const int nx = it + stride;
    __syncthreads();
#pragma unroll
    for (int i = 0; i < 8; ++i) { const int e = tid + i * NTHR; sm[(e >> 6) * 65 + (e & 63)] = r[i]; }
    if (nx < count) { dn = desc_of(nx); TT_LOAD(dn, rn); }
    __syncthreads();
    { const int n = tid >> 3, kc = tid & 7;
      float f[8];
#pragma unroll
      for (int q = 0; q < 8; ++q) f[q] = sm[(kc * 8 + q) * 65 + n];
      u32x4 w; w.x = cvt_pk_bf16(f[0], f[1]); w.y = cvt_pk_bf16(f[2], f[3]); w.z = cvt_pk_bf16(f[4], f[5]); w.w = cvt_pk_bf16(f[6], f[7]);
      *(u32x4*)(d.Wt + (size_t)(d.drow0 + n) * d.K + d.k0 + kc * 8) = w; }
    d = dn;
#pragma unroll
    for (int i = 0; i < 8; ++i) r[i] = rn[i];
  }
#undef TT_LOAD
}
struct ProDesc {
  const float *w_in, *w_oa, *w_ob, *w_out, *g_up; unsigned char* ws;
  static constexpr int I1 = 16 * 86, I2 = 8 * 16, I3 = 8 * 16, I4 = 16 * 16, I5 = 2 * 8, COUNT = I1 + I2 + I3 + I4 + I5;
  __device__ __forceinline__ TDesc operator()(int it) const {
    int r = it;
    if (r < I1) return TDesc{w_in, (bf16_t*)(ws + WS_W1T), INC, (r / 86) * 64, (r % 86) * 64, D, (r % 86) * 64}; r -= I1;
    if (r < I2) return TDesc{w_oa, (bf16_t*)(ws + WS_WOA), D, (r / 16) * 64, (r % 16) * 64, D, (r % 16) * 64}; r -= I2;
    if (r < I3) return TDesc{w_ob, (bf16_t*)(ws + WS_WOA) + 512, D, (r / 16) * 64, (r % 16) * 64, D, (r % 16) * 64}; r -= I3;
    if (r < I4) return TDesc{w_out, (bf16_t*)(ws + WS_WOUT), D, (r / 16) * 64, (r % 16) * 64, D, (r % 16) * 64}; r -= I4;
    return TDesc{g_up, (bf16_t*)(ws + WS_GUPT), 512, (r / 8) * 64, (r % 8) * 64, 128, (r % 8) * 64};
  }
};
constexpr int XT_PER_WG = 24;
struct ExpDesc {
  const float *wg, *wu, *wd; unsigned char* ws;
  static constexpr int COUNT = 3 * 2048;
  __device__ __forceinline__ TDesc operator()(int it) const {
    const int mat = it >> 11, r = it & 2047, e = r >> 6, q = r & 63;
    if (mat < 2) { const int kt = q >> 2, j0 = (q & 3) * 64;
      return TDesc{(mat ? wu : wg) + (size_t)e * D * 256, (bf16_t*)(ws + WS_WGU) + (size_t)e * 512 * D, 256, kt * 64, j0, D, (j0 >> 7) * 256 + mat * 128 + (j0 & 127)}; }
    const int kt = q >> 4, ntl = q & 15;
    return TDesc{wd + (size_t)e * 256 * D, (bf16_t*)(ws + WS_WD) + (size_t)e * D * 256, D, kt * 64, ntl * 64, 256, ntl * 64};
  }
};

__device__ void phase_prologue(const Params& P, float* sm) {
  bf16_t* W1T = (bf16_t*)(P.ws + WS_W1T); bf16_t* WOA = (bf16_t*)(P.ws + WS_WOA); bf16_t* WOB = (bf16_t*)(P.ws + WS_WOB); bf16_t* WOUT = (bf16_t*)(P.ws + WS_WOUT);
  { const ProDesc pd{P.in[2], P.in[23], P.in[24], P.in[25], P.in[13], P.ws}; transpose_items((int)blockIdx.x, ProDesc::COUNT, (int)gridDim.x, pd, sm); }
  {
    u32x4* z = (u32x4*)(W1T + (size_t)INC * D);
    for (int i = blockIdx.x * NTHR + threadIdx.x; i < 16384; i += gridDim.x * NTHR) z[i] = (u32x4){0u, 0u, 0u, 0u};
  }
  if (blockIdx.x == 0 && threadIdx.x < 64) ((int*)(P.ws + WS_CNT))[threadIdx.x] = 0;
  { float* WR = (float*)(P.ws + WS_WR); const float* w_rg = P.in[27]; const float* w_re = P.in[29];
    for (int e = blockIdx.x * NTHR + threadIdx.x; e < D * 48; e += gridDim.x * NTHR) { const int k = e / 48, o = e - k * 48; WR[e] = o < 32 ? w_re[k * 32 + o] : (o < 36 ? w_rg[k * 4 + o - 32] : 0.f); } }

  const float* x = P.in[0]; const float* g = P.in[1]; bf16_t* H = (bf16_t*)(P.ws + WS_H);
  const int lane = threadIdx.x & 63, gw = blockIdx.x * 8 + (threadIdx.x >> 6), ngw = gridDim.x * 8;
  f32x4 gv[4];
#pragma unroll
  for (int j = 0; j < 4; ++j) gv[j] = *(const f32x4*)(g + (lane + 64 * j) * 4);
  f32x4 vc[4], vn[4];
#define NRM_LOAD(V, M) do { _Pragma("unroll") for (int j_ = 0; j_ < 4; ++j_) V[j_] = __builtin_nontemporal_load((const f32x4*)(x + (size_t)(M) * D) + lane + 64 * j_); } while (0)
  if (gw < NTOK) NRM_LOAD(vc, gw);
  for (int m = gw; m < NTOK; m += ngw) {
    if (m + ngw < NTOK) NRM_LOAD(vn, m + ngw);
    float ss = 0.f;
#pragma unroll
    for (int j = 0; j < 4; ++j) ss += vc[j][0] * vc[j][0] + vc[j][1] * vc[j][1] + vc[j][2] * vc[j][2] + vc[j][3] * vc[j][3];
    ss = wave_sum(ss);
    const float rs = __builtin_amdgcn_rsqf(ss * (1.f / D) + 1e-6f);
#pragma unroll
    for (int j = 0; j < 4; ++j) {
      const f32x4 t = vc[j] * rs * gv[j];
      u32x2 o; o.x = cvt_pk_bf16(t[0], t[1]); o.y = cvt_pk_bf16(t[2], t[3]);
      *(u32x2*)(H + (size_t)m * D + (lane + 64 * j) * 4) = o;
    }
#pragma unroll
    for (int j = 0; j < 4; ++j) vc[j] = vn[j];
  }
#undef NRM_LOAD
}

__device__ __forceinline__ float fast_tanh(float x) { return 1.f - 2.f * __builtin_amdgcn_rcpf(__expf(2.f * x) + 1.f); }
__device__ void phase_scan(const Params& P, LAS unsigned char* lds) {
  const GB gws = GB_WS(P);
  constexpr int L_UPW = 0, L_UPA = 8192, L_INW = 16384, L_INA = 24576, L_RKV = 32768,
                L_AABT = 32768, L_AAKT = 36864, L_ABRT = 38912, L_AKRT = 40960, L_TT = 43008,
                L_XT = 45056,
                L_INVN = 81920, L_BON = 82176, L_MU = 83200, L_GAM = 85760,
                L_AT = 87040, L_BT = 95232, L_KT = 103424, L_RT = 111616, L_VT = 136192, L_RAW = 87040;
  const bf16_t* Pm = (const bf16_t*)(P.ws + WS_P);
  float* yd = P.out;
  float* sd = (float*)(P.ws + WS_SD);
  bf16_t* vblk = (bf16_t*)(P.ws + WS_VBLK);
  int tid_ = threadIdx.x; asm volatile("" : "+v"(tid_));
  const int tid = tid_, wid = __builtin_amdgcn_readfirstlane(tid >> 6), lane = tid & 63, fr = lane & 15, fq = lane >> 4;
  const int tok_s = tid >> 3, cch = tid & 7;
  const int nt = wid & 3, mth = wid >> 2;
  const int cE = 16 * nt + fr;
  LAS float* invn = (LAS float*)(lds + L_INVN); LAS float* bon = (LAS float*)(lds + L_BON); LAS float* mus = (LAS float*)(lds + L_MU); LAS float* gam = (LAS float*)(lds + L_GAM);
  for (int chain = blockIdx.x; chain < 256; chain += gridDim.x) {
    const int dir = chain >> 7, b = (chain >> 3) & 15, h = chain & 7;
    const float* w0 = P.in[dir ? 7 : 5]; const float* wu = P.in[dir ? 8 : 6]; const float* a0 = P.in[dir ? 11 : 9]; const float* au = P.in[dir ? 12 : 10];
    __syncthreads();
#pragma unroll
    for (int i = 0; i < 8; ++i) { const int e = tid + i * NTHR, j = e >> 6, c = e & 63;
      const int off = c * 128 + (((j >> 3) ^ (c & 7)) << 4) + (j & 7) * 2;
      *(LAS bf16_t*)(lds + L_UPW + off) = f2bf(wu[j * 512 + h * 64 + c]); *(LAS bf16_t*)(lds + L_UPA + off) = f2bf(au[j * 512 + h * 64 + c]); }
    for (int e = tid; e < 640; e += NTHR) { const int which = e / 320, r = e % 320, seg = r >> 6, c = r & 63;
      const int col = (seg == 0 ? C_R + h * 64 : seg == 1 ? C_K + h * 64 : seg == 2 ? C_V + h * 64 : seg == 3 ? C_WL + dir * 64 : C_AL + dir * 64) + c;
      mus[e] = P.in[3 + which][col]; }
    float kks[8];
#pragma unroll
    for (int j = 0; j < 8; ++j) kks[j] = P.in[14][h * 64 + cch * 8 + j];
    const float w0c = w0[h * 64 + cE], a0c = a0[h * 64 + cE], kkc = P.in[14][h * 64 + cE], kac = P.in[15][h * 64 + cE], rkc = P.in[16][h * 64 + cE];
    f32x4 S[4];
#pragma unroll
    for (int j = 0; j < 4; ++j) S[j] = (f32x4){0.f, 0.f, 0.f, 0.f};
    u32x4 pc[5], ph = (u32x4){0u, 0u, 0u, 0u};
#define SCAN_LOAD(NB) do { const int sidx_ = (NB) * 64 + tok_s; const int tt_ = dir ? (T - 1 - sidx_) : sidx_; \
      const bf16_t* rowp_ = Pm + ptok(b * T + tt_); \
      _Pragma("unroll") for (int seg = 0; seg < 5; ++seg) { \
        const int col_ = (seg == 0 ? C_R + h * 64 : seg == 1 ? C_K + h * 64 : seg == 2 ? C_V + h * 64 : seg == 3 ? C_WL + dir * 64 : C_AL + dir * 64) + cch * 8; \
        pc[seg] = ld16(gws, rowp_ + pcol(col_)); } \
      if (tid < 80) { const int hs_ = (NB) * 64 + (tid >= 40 ? 64 : -1); const int th_ = dir ? (T - 1 - hs_) : hs_; const int sg_ = (tid % 40) >> 3; \
        const int colh_ = (sg_ == 0 ? C_R + h * 64 : sg_ == 1 ? C_K + h * 64 : sg_ == 2 ? C_V + h * 64 : sg_ == 3 ? C_WL + dir * 64 : C_AL + dir * 64) + (tid & 7) * 8; \
        ph = (u32x4){0u, 0u, 0u, 0u}; if (th_ >= 0 && th_ < T) ph = ld16(gws, Pm + ptok(b * T + th_) + pcol(colh_)); } } while (0)
    SCAN_LOAD(0);
    const ExpDesc xed{P.in[31], P.in[32], P.in[33], P.ws};
    const bool xdo = (chain == (int)blockIdx.x) && wid >= 4;
#define XT_LOAD(J) do { const int it_ = (int)blockIdx.x + (J) * (int)gridDim.x; if (xdo && (J) < XT_PER_WG && it_ < ExpDesc::COUNT) { const TDesc d_ = xed(it_); \
        const float* sp_ = d_.W + (size_t)(d_.k0 + (lane >> 2)) * d_.ldw + d_.n0 + 16 * (wid - 4) + 4 * (lane & 3); \
        _Pragma("unroll") for (int j_ = 0; j_ < 4; ++j_) S[j_] = __builtin_nontemporal_load((const f32x4*)(sp_ + (size_t)(16 * j_) * d_.ldw)); } } while (0)
    XT_LOAD(0);
    for (int nb = 0; nb < 32; ++nb) {
      __syncthreads();
      {
#pragma unroll
        for (int seg = 0; seg < 5; ++seg) *(LAS u32x4*)(lds + L_RAW + ((tok_s + 1) * 5 + seg) * 128 + cch * 16) = pc[seg];
        if (tid < 80) *(LAS u32x4*)(lds + L_RAW + ((tid >= 40 ? 65 : 0) * 5) * 128 + (tid % 40) * 16) = ph;
      }
      if (nb + 1 < 32) SCAN_LOAD(nb + 1);
      __syncthreads();
      {
        const int rp = dir ? tok_s + 2 : tok_s, rn = dir ? tok_s : tok_s + 2;
#pragma unroll
        for (int seg = 0; seg < 5; ++seg) {
          const u32x4 c4 = *(const LAS u32x4*)(lds + L_RAW + ((tok_s + 1) * 5 + seg) * 128 + cch * 16);
          const u32x4 p4 = *(const LAS u32x4*)(lds + L_RAW + (rp * 5 + seg) * 128 + cch * 16), n4 = *(const LAS u32x4*)(lds + L_RAW + (rn * 5 + seg) * 128 + cch * 16);
          float cf[8], pf[8], nf[8], val[8]; unpack8f(c4, cf); unpack8f(p4, pf); unpack8f(n4, nf);
          const f32x4 mp0 = *(const LAS f32x4*)(mus + seg * 64 + cch * 8), mp1 = *(const LAS f32x4*)(mus + seg * 64 + cch * 8 + 4);
          const f32x4 mn0 = *(const LAS f32x4*)(mus + 320 + seg * 64 + cch * 8), mn1 = *(const LAS f32x4*)(mus + 320 + seg * 64 + cch * 8 + 4);
#pragma unroll
          for (int j = 0; j < 8; ++j) { const float mp = j < 4 ? mp0[j & 3] : mp1[j & 3], mn = j < 4 ? mn0[j & 3] : mn1[j & 3]; val[j] = cf[j] + mp * (pf[j] - cf[j]) + mn * (nf[j] - cf[j]); }
          if (seg < 3) {
            LAS float* dst = (LAS float*)(lds + L_RKV + seg * 16384) + tok_s * 64 + cch * 8;
            *(LAS f32x4*)dst = (f32x4){val[0], val[1], val[2], val[3]}; *(LAS f32x4*)(dst + 4) = (f32x4){val[4], val[5], val[6], val[7]};
            if (seg == 1) { float ss = 0.f;
#pragma unroll
              for (int j = 0; j < 8; ++j) { const float q = val[j] * kks[j]; ss += q * q; }
              ss = sum8(ss);
              if (cch == 0) invn[tok_s] = __builtin_amdgcn_rsqf(ss + 1e-12f); }
          } else {
            if (seg == 3) {
#pragma unroll
              for (int j = 0; j < 8; ++j) val[j] = fast_tanh(val[j]); }
            u32x4 w; w.x = cvt_pk_bf16(val[0], val[1]); w.y = cvt_pk_bf16(val[2], val[3]); w.z = cvt_pk_bf16(val[4], val[5]); w.w = cvt_pk_bf16(val[6], val[7]);
            *(LAS u32x4*)(lds + (seg == 3 ? L_INW : L_INA) + tok_s * 128 + ((cch ^ (tok_s & 7)) << 4)) = w;
          }
        } }
      __syncthreads();
      { bf16x8 bw[2], ba[2];
#pragma unroll
        for (int ks = 0; ks < 2; ++ks) { const int o = cE * 128 + (((ks * 4 + fq) ^ (cE & 7)) << 4); bw[ks] = *(const LAS bf16x8*)(lds + L_UPW + o); ba[ks] = *(const LAS bf16x8*)(lds + L_UPA + o); }
#pragma unroll 1
        for (int mi = 0; mi < 2; ++mi) {
          const int mt = 2 * mth + mi, tok0 = 16 * mt + 4 * fq;
          f32x4 accWm = (f32x4){0.f, 0.f, 0.f, 0.f}, accAm = accWm;
          { const int trow = 16 * mt + fr;
#pragma unroll
            for (int ks = 0; ks < 2; ++ks) { const int o = trow * 128 + (((ks * 4 + fq) ^ (trow & 7)) << 4);
              accWm = __builtin_amdgcn_mfma_f32_16x16x32_bf16(*(const LAS bf16x8*)(lds + L_INW + o), bw[ks], accWm, 0, 0, 0);
              accAm = __builtin_amdgcn_mfma_f32_16x16x32_bf16(*(const LAS bf16x8*)(lds + L_INA + o), ba[ks], accAm, 0, 0, 0); } }
          float lw[4], kd[4], al_[4], be[4], rr[4], vv[4], bx4[4];
          unsigned rkvb = (unsigned)(size_t)(lds + L_RKV) + (unsigned)((tok0 * 64 + cE) * 4); asm volatile("" : "+v"(rkvb));
          const f32x4 inv4 = *(const LAS f32x4*)(invn + tok0);
#pragma unroll
          for (int rg = 0; rg < 4; ++rg) { const int tok = tok0 + rg;
            lw[rg] = -0.6065306597126334f * sigmoidf_(accWm[rg] + w0c);
            const float a = sigmoidf_(accAm[rg] + a0c);
            const float r = *(const LAS float*)(size_t)(rkvb + rg * 256), k = *(const LAS float*)(size_t)(rkvb + rg * 256 + 16384), v = *(const LAS float*)(size_t)(rkvb + rg * 256 + 32768);
            const float kkv = k * kkc * inv4[rg];
            kd[rg] = k * (1.f + (a - 1.f) * kac); al_[rg] = -kkv; be[rg] = kkv * a; rr[rg] = r; vv[rg] = v;
            bx4[rg] = r * kd[rg] * rkc; }
          { const float bs = sum16x4(bx4, fr); if (fr < 4) bon[nt * 64 + tok0 + fr] = bs; }
          float Lc[4]; Lc[0] = lw[0]; Lc[1] = Lc[0] + lw[1]; Lc[2] = Lc[1] + lw[2]; Lc[3] = Lc[2] + lw[3];
          { const float g = Lc[3]; const float t1 = __shfl_up(g, 16), t2 = __shfl_up(g, 32), t3 = __shfl_up(g, 48);
            const float e = (fq >= 1 ? t1 : 0.f) + (fq >= 2 ? t2 : 0.f) + (fq >= 3 ? t3 : 0.f);
#pragma unroll
            for (int rg = 0; rg < 4; ++rg) Lc[rg] += e; }
          const float L16 = __shfl(Lc[3], 48 + fr);
          { float va[4], vb[4], vk[4], vr2[4];
            float eLprev = __expf(Lc[0] - lw[0]);
#pragma unroll
            for (int rg = 0; rg < 4; ++rg) { const float eL = __expf(Lc[rg]), enL = __builtin_amdgcn_rcpf(eL);
              va[rg] = al_[rg] * eLprev; vb[rg] = be[rg] * enL; vk[rg] = kd[rg] * enL; vr2[rg] = rr[rg] * eL; eLprev = eL; }
#pragma unroll
            for (int pr = 0; pr < 2; ++pr) { const int tk0 = tok0 + 2 * pr, tk1 = tk0 + 1;
              const int off0 = tk0 * 128 + (((cE >> 3) ^ (tk0 & 7)) << 4) + (cE & 7) * 2, off1 = tk1 * 128 + (((cE >> 3) ^ (tk1 & 7)) << 4) + (cE & 7) * 2;
              unsigned q0 = (unsigned)(size_t)(lds + L_AT) + (unsigned)off0, q1 = (unsigned)(size_t)(lds + L_AT) + (unsigned)off1; asm volatile("" : "+v"(q0), "+v"(q1));
#define IMG(q, L) (*(LAS bf16_t*)(size_t)((q) + ((L) - L_AT)))
              const unsigned pa = cvt_pk_bf16(va[2 * pr], va[2 * pr + 1]), pb = cvt_pk_bf16(vb[2 * pr], vb[2 * pr + 1]), pk = cvt_pk_bf16(vk[2 * pr], vk[2 * pr + 1]),
                             pq = cvt_pk_bf16(vr2[2 * pr], vr2[2 * pr + 1]), pv = cvt_pk_bf16(vv[2 * pr], vv[2 * pr + 1]);
              IMG(q0, L_AT) = (bf16_t)pa; IMG(q1, L_AT) = (bf16_t)(pa >> 16);
              IMG(q0, L_BT) = (bf16_t)pb; IMG(q1, L_BT) = (bf16_t)(pb >> 16);
              IMG(q0, L_KT) = (bf16_t)pk; IMG(q1, L_KT) = (bf16_t)(pk >> 16);
              IMG(q0, L_RT) = (bf16_t)pq; IMG(q1, L_RT) = (bf16_t)(pq >> 16);
              IMG(q0, L_VT) = (bf16_t)pv; IMG(q1, L_VT) = (bf16_t)(pv >> 16);
#undef IMG
            } }
          if (fq == 0) gam[mt * 64 + cE] = __expf(L16);
          if (dir == 0) { u32x2 w; w.x = cvt_pk_bf16(vv[0], vv[1]); w.y = cvt_pk_bf16(vv[2], vv[3]);
            *(u32x2*)(vblk + ((((size_t)b * 8 + h) * 128 + nb * 4 + mt) * 4 + nt) * 256 + lane * 4) = w; }
        } }
      __syncthreads();
      { const int sc = wid >> 1, pp = wid & 1, rowA = 16 * sc + fr, sw = rowA & 7;
        const f32x4 z = (f32x4){0.f, 0.f, 0.f, 0.f};
#define OPND(a) __builtin_bit_cast(bf16x8, ((u32x4){cvt_pk_bf16((a)[0], (a)[1]), cvt_pk_bf16((a)[2], (a)[3]), 0u, 0u}))
        if (pp == 0) {
          f32x4 nt = z, nm = z, d2 = z;
#pragma unroll
          for (int ks = 0; ks < 2; ++ks) { const int o = rowA * 128 + (((ks * 4 + fq) ^ sw) << 4);
            const bf16x8 fa = *(const LAS bf16x8*)(lds + L_AT + o), fb = *(const LAS bf16x8*)(lds + L_BT + o), fk = *(const LAS bf16x8*)(lds + L_KT + o);
            nt = __builtin_amdgcn_mfma_f32_16x16x32_bf16(fb, fa, nt, 0, 0, 0);
            nm = __builtin_amdgcn_mfma_f32_16x16x32_bf16(fa, fb, nm, 0, 0, 0);
            d2 = __builtin_amdgcn_mfma_f32_16x16x32_bf16(fk, fa, d2, 0, 0, 0); }
#pragma unroll
          for (int rg = 0; rg < 4; ++rg) { const int rr = 4 * fq + rg;
            nt[rg] = rr < fr ? nt[rg] : 0.f; d2[rg] = rr < fr ? d2[rg] : 0.f;
            nm[rg] = rr > fr ? nm[rg] : 0.f; }
          { u32x2 w2; w2.x = cvt_pk_bf16(d2[0], d2[1]); w2.y = cvt_pk_bf16(d2[2], d2[3]); *(LAS u32x2*)(lds + L_AAKT + sc * 512 + fr * 32 + fq * 8) = w2; }
          f32x4 X = nm, Xt = nt, Pm_ = nm, Pt_ = nt;
#pragma unroll
          for (int rg = 0; rg < 4; ++rg) { const float one = (4 * fq + rg == fr) ? 1.f : 0.f; X[rg] += one; Xt[rg] += one; }
#pragma unroll
          for (int it = 0; it < 3; ++it) {
            const bf16x8 oP = OPND(Pm_), oPt = OPND(Pt_);
            const f32x4 P2 = __builtin_amdgcn_mfma_f32_16x16x32_bf16(oPt, oP, z, 0, 0, 0);
            const f32x4 P2t = __builtin_amdgcn_mfma_f32_16x16x32_bf16(oP, oPt, z, 0, 0, 0);
            const bf16x8 oX = OPND(X), oXt = OPND(Xt), oP2 = OPND(P2), oP2t = OPND(P2t);
            const f32x4 Xn = __builtin_amdgcn_mfma_f32_16x16x32_bf16(oXt, oP2, X, 0, 0, 0);
            const f32x4 Xtn = __builtin_amdgcn_mfma_f32_16x16x32_bf16(oP2, oXt, Xt, 0, 0, 0);
            (void)oX; (void)oP2t;
            X = Xn; Xt = Xtn; Pm_ = P2; Pt_ = P2t;
          }
          { u32x2 w; w.x = cvt_pk_bf16(Xt[0], Xt[1]); w.y = cvt_pk_bf16(Xt[2], Xt[3]); *(LAS u32x2*)(lds + L_TT + sc * 512 + fr * 32 + fq * 8) = w; }
        } else {
          f32x4 d1 = z, d2 = z;
#pragma unroll
          for (int ks = 0; ks < 2; ++ks) { const int o = rowA * 128 + (((ks * 4 + fq) ^ sw) << 4);
            const bf16x8 yb = *(const LAS bf16x8*)(lds + L_RT + o);
            d1 = __builtin_amdgcn_mfma_f32_16x16x32_bf16(*(const LAS bf16x8*)(lds + L_BT + o), yb, d1, 0, 0, 0);
            d2 = __builtin_amdgcn_mfma_f32_16x16x32_bf16(*(const LAS bf16x8*)(lds + L_KT + o), yb, d2, 0, 0, 0); }
#pragma unroll
          for (int rg = 0; rg < 4; ++rg) { const bool keep = (4 * fq + rg) <= fr; d1[rg] = keep ? d1[rg] : 0.f; d2[rg] = keep ? d2[rg] : 0.f; }
          u32x2 w1, w2; w1.x = cvt_pk_bf16(d1[0], d1[1]); w1.y = cvt_pk_bf16(d1[2], d1[3]); w2.x = cvt_pk_bf16(d2[0], d2[1]); w2.y = cvt_pk_bf16(d2[2], d2[3]);
          *(LAS u32x2*)(lds + L_ABRT + sc * 512 + fr * 32 + fq * 8) = w1; *(LAS u32x2*)(lds + L_AKRT + sc * 512 + fr * 32 + fq * 8) = w2;
          if (wid == 1) { const int sidx = nb * 64 + lane; const int tt = dir ? (T - 1 - sidx) : sidx;
            sd[((size_t)dir * 128 + b * 8 + h) * T + tt] = (bon[lane] + bon[64 + lane]) + (bon[128 + lane] + bon[192 + lane]); }
        }
#undef OPND
      }
      __syncthreads();
      if (wid >= 4) {
        const int it = (int)blockIdx.x + nb * (int)gridDim.x;
        if (xdo && nb < XT_PER_WG && it < ExpDesc::COUNT) {
          const TDesc d = xed(it);
          LAS unsigned char* xp = lds + L_XT + (wid - 4) * 2048;
#pragma unroll
          for (int j = 0; j < 4; ++j) { const unsigned p0 = cvt_pk_bf16(S[j][0], S[j][1]), p1 = cvt_pk_bf16(S[j][2], S[j][3]);
            LAS unsigned char* q = xp + (4 * (lane & 3)) * 128 + (16 * j + (lane >> 2)) * 2;
            *(LAS bf16_t*)(q) = (bf16_t)p0; *(LAS bf16_t*)(q + 128) = (bf16_t)(p0 >> 16);
            *(LAS bf16_t*)(q + 256) = (bf16_t)p1; *(LAS bf16_t*)(q + 384) = (bf16_t)(p1 >> 16); }
          asm volatile("s_waitcnt lgkmcnt(0)" ::: "memory");
#pragma unroll
          for (int i = 0; i < 2; ++i) { const int c = lane + 64 * i, nl = c >> 3, kc = c & 7;
            const u32x4 w = *(const LAS u32x4*)(xp + nl * 128 + kc * 16);
            *(u32x4*)(d.Wt + (size_t)(d.drow0 + 16 * (wid - 4) + nl) * d.K + d.k0 + kc * 8) = w; }
          asm volatile("" ::: "memory");
        }
        XT_LOAD(nb + 1);
      }
      if (wid < 4) {
#pragma unroll 2
        for (int sc = 0; sc < 4; ++sc) {
          const int rowt = 16 * sc + fr, swt = rowt & 7;
          u32x4 sb0, sb1;
          sb0.x = cvt_pk_bf16(S[0][0], S[0][1]); sb0.y = cvt_pk_bf16(S[0][2], S[0][3]); sb0.z = cvt_pk_bf16(S[1][0], S[1][1]); sb0.w = cvt_pk_bf16(S[1][2], S[1][3]);
          sb1.x = cvt_pk_bf16(S[2][0], S[2][1]); sb1.y = cvt_pk_bf16(S[2][2], S[2][3]); sb1.z = cvt_pk_bf16(S[3][0], S[3][1]); sb1.w = cvt_pk_bf16(S[3][2], S[3][3]);
          const bf16x8 Sb0 = __builtin_bit_cast(bf16x8, sb0), Sb1 = __builtin_bit_cast(bf16x8, sb1);
          const int rowv = 16 * sc + 4 * fq + (fr >> 2), pq = fr & 3;
          s16x4 vf, bhf[4], khf[4];
          { const int va = L_VT + rowv * 128 + (((2 * wid + (pq >> 1)) ^ (rowv & 7)) << 4) + (pq & 1) * 8;
            vf = lds_tr16(lds, va); }
#pragma unroll
          for (int jt = 0; jt < 4; ++jt) { const int o = rowv * 128 + (((2 * jt + (pq >> 1)) ^ (rowv & 7)) << 4) + (pq & 1) * 8;
            bhf[jt] = lds_tr16(lds, L_BT + o); khf[jt] = lds_tr16(lds, L_KT + o); }
          u32x2 alo[2], ahi[2], rlo[2], rhi[2];
#pragma unroll
          for (int ks = 0; ks < 2; ++ks) { const int c1 = 4 * ks + (fq >> 1), sub = 8 * (fq & 1);
            const int o1 = rowt * 128 + ((c1 ^ swt) << 4) + sub, o2 = rowt * 128 + (((c1 + 2) ^ swt) << 4) + sub;
            alo[ks] = *(const LAS u32x2*)(lds + L_AT + o1); ahi[ks] = *(const LAS u32x2*)(lds + L_AT + o2);
            rlo[ks] = *(const LAS u32x2*)(lds + L_RT + o1); rhi[ks] = *(const LAS u32x2*)(lds + L_RT + o2); }
          const u32x2 aak = *(const LAS u32x2*)(lds + L_AAKT + sc * 512 + fr * 32 + fq * 8), ttf = *(const LAS u32x2*)(lds + L_TT + sc * 512 + fr * 32 + fq * 8);
          const u32x2 abr = *(const LAS u32x2*)(lds + L_ABRT + sc * 512 + fr * 32 + fq * 8), akr = *(const LAS u32x2*)(lds + L_AKRT + sc * 512 + fr * 32 + fq * 8);
          f32x4 gm[4];
#pragma unroll
          for (int jt = 0; jt < 4; ++jt) gm[jt] = *(const LAS f32x4*)(gam + sc * 64 + 16 * jt + 4 * fq);
          const u32x2 vfu = __builtin_bit_cast(u32x2, vf);
          const f32x4 z = (f32x4){0.f, 0.f, 0.f, 0.f};
          f32x4 Up = __builtin_amdgcn_mfma_f32_16x16x32_bf16(__builtin_bit_cast(bf16x8, ((u32x4){alo[0].x, alo[0].y, ahi[0].x, ahi[0].y})), Sb0, z, 0, 0, 0);
          Up = __builtin_amdgcn_mfma_f32_16x16x32_bf16(__builtin_bit_cast(bf16x8, ((u32x4){alo[1].x, alo[1].y, ahi[1].x, ahi[1].y})), Sb1, Up, 0, 0, 0);
          Up = __builtin_amdgcn_mfma_f32_16x16x32_bf16(__builtin_bit_cast(bf16x8, ((u32x4){aak.x, aak.y, 0u, 0u})), __builtin_bit_cast(bf16x8, ((u32x4){vfu.x, vfu.y, 0u, 0u})), Up, 0, 0, 0);
          const f32x4 U = __builtin_amdgcn_mfma_f32_16x16x32_bf16(__builtin_bit_cast(bf16x8, ((u32x4){ttf.x, ttf.y, 0u, 0u})),
                                                                  __builtin_bit_cast(bf16x8, ((u32x4){cvt_pk_bf16(Up[0], Up[1]), cvt_pk_bf16(Up[2], Up[3]), 0u, 0u})), z, 0, 0, 0);
          const bf16x8 UB = __builtin_bit_cast(bf16x8, ((u32x4){cvt_pk_bf16(U[0], U[1]), cvt_pk_bf16(U[2], U[3]), vfu.x, vfu.y}));
          f32x4 Y = __builtin_amdgcn_mfma_f32_16x16x32_bf16(__builtin_bit_cast(bf16x8, ((u32x4){rlo[0].x, rlo[0].y, rhi[0].x, rhi[0].y})), Sb0, z, 0, 0, 0);
          Y = __builtin_amdgcn_mfma_f32_16x16x32_bf16(__builtin_bit_cast(bf16x8, ((u32x4){rlo[1].x, rlo[1].y, rhi[1].x, rhi[1].y})), Sb1, Y, 0, 0, 0);
          Y = __builtin_amdgcn_mfma_f32_16x16x32_bf16(__builtin_bit_cast(bf16x8, ((u32x4){abr.x, abr.y, akr.x, akr.y})), UB, Y, 0, 0, 0);
#pragma unroll
          for (int jt = 0; jt < 4; ++jt) { const u32x2 bu = __builtin_bit_cast(u32x2, bhf[jt]), ku = __builtin_bit_cast(u32x2, khf[jt]);
            S[jt] = __builtin_amdgcn_mfma_f32_16x16x32_bf16(__builtin_bit_cast(bf16x8, ((u32x4){bu.x, bu.y, ku.x, ku.y})), UB, S[jt], 0, 0, 0) * gm[jt]; }
          { const int ps = nb * 4 + sc, tile = dir ? 127 - ps : ps;
            *(f32x4*)(yd + ((((size_t)dir * 128 + b * 8 + h) * 128 + tile) * 4 + wid) * 256 + lane * 4) = Y; }
        }
      }
    }
  }
}

#undef XT_LOAD
__device__ void phase_rwkv_post(const Params& P, LAS unsigned char* lds) {
  const GB gws = GB_WS(P), gout = GB_OUT(P);
  constexpr int L_SIG = 0, L_MUG = 16384, L_OUT = 20480;
  const bf16_t* Pm = (const bf16_t*)(P.ws + WS_P); const bf16_t* gupT = (const bf16_t*)(P.ws + WS_GUPT); const bf16_t* vblk = (const bf16_t*)(P.ws + WS_VBLK);
  const float* yd = P.out; const float* sd = (const float*)(P.ws + WS_SD); bf16_t* RY = (bf16_t*)(P.ws + WS_RY);
  int tid_ = threadIdx.x; asm volatile("" : "+v"(tid_));
  const int tid = tid_, wid = __builtin_amdgcn_readfirstlane(tid >> 6), lane = tid & 63, fr = lane & 15, fq = lane >> 4;
  const int tok_s = tid >> 3, cch = tid & 7, h = wid;
  LAS float* mug = (LAS float*)(lds + L_MUG);
  __syncthreads();
  if (tid < 256) mug[tid] = P.in[3 + (tid >> 7)][C_GL + (tid & 127)];
  bf16x8 bg[4][4];
#pragma unroll
  for (int ct = 0; ct < 4; ++ct)
#pragma unroll
    for (int ks = 0; ks < 4; ++ks) bg[ct][ks] = __builtin_bit_cast(bf16x8, ld16(gws, gupT + (size_t)(h * 64 + 16 * ct + fr) * 128 + ks * 32 + fq * 8));
  float lg[4], lb[4];
#pragma unroll
  for (int ct = 0; ct < 4; ++ct) { lg[ct] = P.in[17][h * 64 + 16 * ct + fr]; lb[ct] = P.in[18][h * 64 + 16 * ct + fr]; }
  struct PostIn { f32x4 yf[4], yb[4]; u32x2 vw[4]; f32x4 sf, sb; };
#define POST_LOAD(R, ITEM, MT) do { const int b_ = (ITEM) >> 5, t0_ = ((ITEM) & 31) * 64, tile_ = (t0_ >> 4) + (MT); const size_t bh_ = (size_t)b_ * 8 + h; \
    _Pragma("unroll") for (int ct_ = 0; ct_ < 4; ++ct_) { \
      R.yf[ct_] = ld16f(gout, yd + ((bh_ * 128 + tile_) * 4 + ct_) * 256 + lane * 4); \
      R.yb[ct_] = ld16f(gout, yd + ((((size_t)128 + bh_) * 128 + tile_) * 4 + ct_) * 256 + (fr + 16 * (3 - fq)) * 4);     \
      R.vw[ct_] = ld8(gws, vblk + ((bh_ * 128 + tile_) * 4 + ct_) * 256 + lane * 4); } \
    R.sf = ld16f(gws, sd + bh_ * T + t0_ + 16 * (MT) + 4 * fq); R.sb = ld16f(gws, sd + (128 + bh_) * T + t0_ + 16 * (MT) + 4 * fq); } while (0)
  PostIn cur, nxt;
  if ((int)blockIdx.x < NTOK / 64) POST_LOAD(cur, (int)blockIdx.x, 0);
  for (int item = blockIdx.x; item < NTOK / 64; item += gridDim.x) {
    const int b = item >> 5, t0 = (item & 31) * 64;
    __syncthreads();
    { const int tt = t0 + tok_s; const bf16_t* rowp = Pm + ptok(b * T + tt); const bf16_t* rowpp = Pm + ptok(b * T + tt - (tt > 0 ? 1 : 0)); const bf16_t* rowpn = Pm + ptok(b * T + tt + (tt < T - 1 ? 1 : 0)); const bool hp = tt > 0, hn = tt < T - 1;
#pragma unroll
      for (int half = 0; half < 2; ++half) { const int ch = cch + 8 * half;
        const u32x4 z4 = (u32x4){0u, 0u, 0u, 0u};
        const unsigned co = pcol(C_GL + ch * 8);
        const u32x4 c4 = ld16(gws, rowp + co); const u32x4 p4 = hp ? ld16(gws, rowpp + co) : z4; const u32x4 n4 = hn ? ld16(gws, rowpn + co) : z4;
        float cf[8], pf[8], nf[8], val[8]; unpack8f(c4, cf); unpack8f(p4, pf); unpack8f(n4, nf);
#pragma unroll
        for (int j = 0; j < 8; ++j) val[j] = sigmoidf_(cf[j] + mug[ch * 8 + j] * (pf[j] - cf[j]) + mug[128 + ch * 8 + j] * (nf[j] - cf[j]));
        u32x4 w; w.x = cvt_pk_bf16(val[0], val[1]); w.y = cvt_pk_bf16(val[2], val[3]); w.z = cvt_pk_bf16(val[4], val[5]); w.w = cvt_pk_bf16(val[6], val[7]);
        *(LAS u32x4*)(lds + L_SIG + tok_s * 256 + ((ch ^ (tok_s & 7)) << 4)) = w; } }
    __syncthreads();
#pragma unroll 1
    for (int mt = 0; mt < 4; ++mt) {
      if (mt < 3) POST_LOAD(nxt, item, mt + 1); else if (item + (int)gridDim.x < NTOK / 64) POST_LOAD(nxt, item + (int)gridDim.x, 0);
      const f32x4 sf = cur.sf, sb = cur.sb;
      f32x4 g[4];
      { const int trow = 16 * mt + fr;
        bf16x8 af[4];
#pragma unroll
        for (int ks = 0; ks < 4; ++ks) af[ks] = *(const LAS bf16x8*)(lds + L_SIG + trow * 256 + (((ks * 4 + fq) ^ (trow & 7)) << 4));
#pragma unroll
        for (int ct = 0; ct < 4; ++ct) { f32x4 c = (f32x4){0.f, 0.f, 0.f, 0.f};
#pragma unroll
          for (int ks = 0; ks < 4; ++ks) c = __builtin_amdgcn_mfma_f32_16x16x32_bf16(af[ks], bg[ct][ks], c, 0, 0, 0);
          g[ct] = c; } }
      f32x4 y[4];
#pragma unroll
      for (int ct = 0; ct < 4; ++ct) y[ct] = cur.yf[ct] + (f32x4){cur.yb[ct][3], cur.yb[ct][2], cur.yb[ct][1], cur.yb[ct][0]};
      f32x4 sm4 = (y[0] + y[1]) + (y[2] + y[3]);
#pragma unroll
      for (int rg = 0; rg < 4; ++rg) { float x = sm4[rg]; x = sum16(x); sm4[rg] = x * (1.f / 64.f); }
      f32x4 vr = (f32x4){0.f, 0.f, 0.f, 0.f};
#pragma unroll
      for (int ct = 0; ct < 4; ++ct) { y[ct] = y[ct] - sm4; vr += y[ct] * y[ct]; }
#pragma unroll
      for (int rg = 0; rg < 4; ++rg) { float x = vr[rg]; x = sum16(x); vr[rg] = __builtin_amdgcn_rsqf(x * (1.f / 64.f) + 64e-5f); }
      const f32x4 bs = sf + sb;
      LAS unsigned char* ot = lds + L_OUT + wid * 2048;
#pragma unroll
      for (int ct = 0; ct < 4; ++ct) {
        const f32x4 v4 = (f32x4){__uint_as_float(cur.vw[ct].x << 16), __uint_as_float(cur.vw[ct].x & 0xffff0000u), __uint_as_float(cur.vw[ct].y << 16), __uint_as_float(cur.vw[ct].y & 0xffff0000u)};
        const f32x4 o = ((y[ct] * vr) * lg[ct] + lb[ct] + bs * v4) * g[ct];
#pragma unroll
        for (int rg = 0; rg < 4; ++rg) *(LAS bf16_t*)(ot + (4 * fq + rg) * 128 + (16 * ct + fr) * 2) = f2bf(o[rg]);
      }
      asm volatile("s_waitcnt lgkmcnt(0)" ::: "memory");
#pragma unroll
      for (int i = 0; i < 2; ++i) { const int e = lane + 64 * i, r = e >> 3, ch = e & 7;
        const u32x4 w = *(const LAS u32x4*)(ot + r * 128 + ch * 16);
        *(u32x4*)(RY + (size_t)(b * T + t0 + 16 * mt + r) * D + h * 64 + ch * 8) = w; }
      asm volatile("" ::: "memory");
      cur = nxt;
    }
  }
#undef POST_LOAD
}

__device__ void phase_na(const Params& P, LAS unsigned char* lds, int G, int vcu) {
  const GB gws = GB_WS(P);
  const bf16_t* Pm = (const bf16_t*)(P.ws + WS_P); bf16_t* NY = (bf16_t*)(P.ws + WS_NY);
  const float* q_gain = P.in[19]; const float* k_gain = P.in[20]; const float* rpb = P.in[21];
  int tid_ = threadIdx.x; asm volatile("" : "+v"(tid_));
  const int tid = tid_, wid = __builtin_amdgcn_readfirstlane(tid >> 6), lane = tid & 63, fr = lane & 15, fq = lane >> 4;
  constexpr int KOFF = 0, VOFF = 61440, BOFF = 122880;
  LAS float* biasS = (LAS float*)(lds + BOFF);
  float kg[8], qg0[8], qg1[8];
#pragma unroll
  for (int j = 0; j < 8; ++j) { kg[j] = k_gain[(tid & 7) * 8 + j]; qg0[j] = q_gain[fq * 8 + j]; qg1[j] = q_gain[32 + fq * 8 + j]; }
  u32x4 kc[8], vc[8], qraw0, qraw1;
#define NA_GEOM(ITEM) const int cb = (ITEM) & 3, rq = ((ITEM) >> 2) & 3, h = ((ITEM) >> 4) & 7, b = (ITEM) >> 7; const int i0 = rq * 8; \
    const int kr0 = i0 >= 4 ? i0 - 4 : 0; const int krl = i0 + 3 > 24 ? 24 : i0 + 3; const int nkr = krl + 8 - kr0; \
    const int kb = cb == 0 ? 0 : (cb == 1 ? 8 : (cb == 2 ? 24 : 32)); const int nch = nkr * 256;
#define NA_LOAD(ITEM) do { NA_GEOM(ITEM) \
    _Pragma("unroll") for (int it = 0; it < 8; ++it) { const int e = tid + it * NTHR; \
      if (e < nch) { const int row = e >> 3; const size_t tok = (size_t)b * T + (kr0 + (row >> 5)) * 64 + kb + (row & 31); \
        const bf16_t* base = Pm + ptok((int)tok); const int hc_ = h * 64 + (e & 7) * 8; kc[it] = ld16(gws, base + pcol(C_NK + hc_)); vc[it] = ld16(gws, base + pcol(C_NV + hc_)); } } \
    { const bf16_t* qp_ = Pm + ptok(b * T + (i0 + wid) * 64 + cb * 16 + fr); qraw0 = ld16(gws, qp_ + pcol(C_Q + h * 64 + fq * 8)); qraw1 = ld16(gws, qp_ + pcol(C_Q + h * 64 + 32 + fq * 8)); } } while (0)
  if (vcu < 2048) NA_LOAD(vcu);
  for (int item = vcu; item < 2048; item += G) {
    NA_GEOM(item)
    __syncthreads();
    if (tid < 465) biasS[tid] = rpb[h * 465 + tid];
#pragma unroll
    for (int it = 0; it < 8; ++it) { const int e = tid + it * NTHR;
      if (e < nch) { const int row = e >> 3; float f[8]; unpack8f(kc[it], f);
        float ss = 0.f;
#pragma unroll
        for (int j = 0; j < 8; ++j) ss += f[j] * f[j];
        ss = sum8(ss);
        const float sc = __builtin_amdgcn_rsqf(ss * (1.f / 64.f) + 1e-6f);
        u32x4 w; w.x = cvt_pk_bf16(f[0] * sc * kg[0], f[1] * sc * kg[1]); w.y = cvt_pk_bf16(f[2] * sc * kg[2], f[3] * sc * kg[3]);
        w.z = cvt_pk_bf16(f[4] * sc * kg[4], f[5] * sc * kg[5]); w.w = cvt_pk_bf16(f[6] * sc * kg[6], f[7] * sc * kg[7]);
        const int off = row * 128 + (((e & 7) ^ (row & 7)) << 4);
        *(LAS u32x4*)(lds + KOFF + off) = w; *(LAS u32x4*)(lds + VOFF + off) = vc[it]; } }
    const u32x4 qc0 = qraw0, qc1 = qraw1;
    if (item + G < 2048) NA_LOAD(item + G);
    __syncthreads();
    const int i = i0 + wid;
    const size_t qtok = (size_t)b * T + i * 64 + cb * 16 + fr;
    bf16x8 qf0, qf1;
    { float f0[8], f1[8]; unpack8f(qc0, f0); unpack8f(qc1, f1);
      float ss = 0.f;
#pragma unroll
      for (int j = 0; j < 8; ++j) ss += f0[j] * f0[j] + f1[j] * f1[j];
      ss += __shfl_xor(ss, 16); ss += __shfl_xor(ss, 32);
      const float sc = __builtin_amdgcn_rsqf(ss * (1.f / 64.f) + 1e-6f) * 0.125f;
      u32x4 w0, w1;
      w0.x = cvt_pk_bf16(f0[0] * sc * qg0[0], f0[1] * sc * qg0[1]); w0.y = cvt_pk_bf16(f0[2] * sc * qg0[2], f0[3] * sc * qg0[3]);
      w0.z = cvt_pk_bf16(f0[4] * sc * qg0[4], f0[5] * sc * qg0[5]); w0.w = cvt_pk_bf16(f0[6] * sc * qg0[6], f0[7] * sc * qg0[7]);
      w1.x = cvt_pk_bf16(f1[0] * sc * qg1[0], f1[1] * sc * qg1[1]); w1.y = cvt_pk_bf16(f1[2] * sc * qg1[2], f1[3] * sc * qg1[3]);
      w1.z = cvt_pk_bf16(f1[4] * sc * qg1[4], f1[5] * sc * qg1[5]); w1.w = cvt_pk_bf16(f1[6] * sc * qg1[6], f1[7] * sc * qg1[7]);
      qf0 = __builtin_bit_cast(bf16x8, w0); qf1 = __builtin_bit_cast(bf16x8, w1); }
    int rs_i = i - 4; rs_i = rs_i < 0 ? 0 : (rs_i > 24 ? 24 : rs_i);
    const int lrow0 = rs_i - kr0;
    f32x4 acc[16];
    { const int sw = fr & 7;
      const int ka = KOFF + ((lrow0 * 32 + fr) * 128);
#pragma unroll
      for (int t = 0; t < 16; ++t) {
        const int addr = ka + ((t >> 1) * 32 + (t & 1) * 16) * 128;
        const bf16x8 a0 = *(const LAS bf16x8*)(lds + addr + ((fq ^ sw) << 4));
        const bf16x8 a1 = *(const LAS bf16x8*)(lds + addr + (((4 + fq) ^ sw) << 4));
        f32x4 c = (f32x4){0.f, 0.f, 0.f, 0.f};
        c = __builtin_amdgcn_mfma_f32_16x16x32_bf16(a0, qf0, c, 0, 0, 0);
        acc[t] = __builtin_amdgcn_mfma_f32_16x16x32_bf16(a1, qf1, c, 0, 0, 0);
      } }
    const int qc = cb * 16 + fr;
    int cs = qc - 8; cs = cs < 0 ? 0 : (cs > 48 ? 48 : cs);
    const int dr0 = rs_i - i + 7;
    bool v0[4]; int dcs[4];
#pragma unroll
    for (int rg = 0; rg < 4; ++rg) { const int kcol0 = kb + 4 * fq + rg; v0[rg] = kcol0 >= cs; dcs[rg] = (v0[rg] ? kcol0 : kcol0 + 16) - qc + 15; }
    float mx = -3.0e38f;
#pragma unroll
    for (int s2 = 0; s2 < 8; ++s2)
#pragma unroll
      for (int rg = 0; rg < 4; ++rg) {
        const float sv = (v0[rg] ? acc[2 * s2][rg] : acc[2 * s2 + 1][rg]) + biasS[(dr0 + s2) * 31 + dcs[rg]];
        acc[2 * s2][rg] = sv; mx = fmaxf(mx, sv);
      }
    mx = fmaxf(mx, __shfl_xor(mx, 16)); mx = fmaxf(mx, __shfl_xor(mx, 32));
    float sum = 0.f;
#pragma unroll
    for (int s2 = 0; s2 < 8; ++s2)
#pragma unroll
      for (int rg = 0; rg < 4; ++rg) { const float pv = __expf(acc[2 * s2][rg] - mx); sum += pv; acc[2 * s2][rg] = v0[rg] ? pv : 0.f; acc[2 * s2 + 1][rg] = v0[rg] ? 0.f : pv; }
    sum += __shfl_xor(sum, 16); sum += __shfl_xor(sum, 32);
    f32x4 o[4];
#pragma unroll
    for (int db = 0; db < 4; ++db) o[db] = (f32x4){0.f, 0.f, 0.f, 0.f};
    { const int row1 = lrow0 * 32 + 4 * fq + (fr >> 2);
      const int pq = fr & 3;
#pragma unroll
      for (int s2 = 0; s2 < 8; ++s2) {
        u32x4 pw; pw.x = cvt_pk_bf16(acc[2 * s2][0], acc[2 * s2][1]); pw.y = cvt_pk_bf16(acc[2 * s2][2], acc[2 * s2][3]);
        pw.z = cvt_pk_bf16(acc[2 * s2 + 1][0], acc[2 * s2 + 1][1]); pw.w = cvt_pk_bf16(acc[2 * s2 + 1][2], acc[2 * s2 + 1][3]);
        const bf16x8 pb = __builtin_bit_cast(bf16x8, pw);
        const int rowv = row1 + s2 * 32;
        s16x4 lo[4], hi[4];
#pragma unroll
        for (int db = 0; db < 4; ++db) {
          const int va = VOFF + rowv * 128 + (((db * 2 + (pq >> 1)) ^ (rowv & 7)) << 4) + (pq & 1) * 8;
          lo[db] = lds_tr16(lds, va); hi[db] = lds_tr16(lds, va + 2048);
        }
#pragma unroll
        for (int db = 0; db < 4; ++db) {
          const bf16x8 va8 = (bf16x8){lo[db][0], lo[db][1], lo[db][2], lo[db][3], hi[db][0], hi[db][1], hi[db][2], hi[db][3]};
          o[db] = __builtin_amdgcn_mfma_f32_16x16x32_bf16(va8, pb, o[db], 0, 0, 0);
        }
      } }
    const float inv = __builtin_amdgcn_rcpf(sum);
    bf16_t* op = NY + qtok * D + h * 64 + 4 * fq;
#pragma unroll
    for (int db = 0; db < 4; ++db) { u32x2 w; w.x = cvt_pk_bf16(o[db][0] * inv, o[db][1] * inv); w.y = cvt_pk_bf16(o[db][2] * inv, o[db][3] * inv); *(u32x2*)(op + db * 16) = w; }
  }
}

__device__ void phase_router(const Params& P, float* sm) {
  const GB gws = GB_WS(P), gout = GB_OUT(P);
  { const ExpDesc ed{P.in[31], P.in[32], P.in[33], P.ws}; transpose_items((int)blockIdx.x + XT_PER_WG * (int)gridDim.x, ExpDesc::COUNT, (int)gridDim.x, ed, sm); }
  const float* g2 = P.in[26]; const float* w_rg = P.in[27]; const float* b_rg = P.in[28]; const float* w_re = P.in[29]; const float* b_re = P.in[30];
  bf16_t* H2 = (bf16_t*)P.out; const bf16_t* DL = (const bf16_t*)(P.ws + WS_DELTA); int* EID = (int*)(P.ws + WS_EID); float* EW = (float*)(P.ws + WS_EW); int* RANK = (int*)(P.ws + WS_RANK); int* CNT = (int*)(P.ws + WS_CNT);
  float* RSG = (float*)(P.ws + WS_RSG);
  constexpr int XSTR = 260;
  float* xs = sm;
  float* wsm = sm + 64 * XSTR;
  float* rsm = wsm + 256 * 48;
  float* lgm = rsm + 64;
  int tid_ = threadIdx.x; asm volatile("" : "+v"(tid_));
  const int tid = tid_, wid = __builtin_amdgcn_readfirstlane(tid >> 6), lane = tid & 63, fr = lane & 15, fq = lane >> 4;
  const int tok_s = tid >> 3, seg = tid & 7;
  const bool heavy = wid < 4; const int mt = wid & 3;
  for (int item = blockIdx.x; item < NTOK / 64; item += gridDim.x) {
    const int tok0 = item * 64;
    f32x4 acc0 = (f32x4){0.f, 0.f, 0.f, 0.f}, acc1 = acc0;
    float ss = 0.f;
    const float* xrow = P.in[0] + (size_t)(tok0 + tok_s) * D + seg * 4; const bf16_t* drow = DL + (size_t)(tok0 + tok_s) * D + seg * 4; const f32x4* wrp = (const f32x4*)(P.ws + WS_WR) + tid;
    f32x4 xq[8], wq[6]; u32x2 dq[8];
#pragma unroll
    for (int j = 0; j < 8; ++j) { xq[j] = __builtin_nontemporal_load((const f32x4*)(xrow + j * 32)); dq[j] = ld8(gws, drow + j * 32); }
#pragma unroll
    for (int i = 0; i < 6; ++i) wq[i] = ld16f(gws, wrp + i * NTHR);
    for (int kc = 0; kc < 4; ++kc) {
      __syncthreads();
      { const float* gr = g2 + kc * 256 + seg * 4; bf16_t* hr = H2 + (size_t)(tok0 + tok_s) * D + kc * 256 + seg * 4;
#pragma unroll
        for (int j = 0; j < 8; ++j) { const f32x4 g = *(const f32x4*)(gr + j * 32);
          const f32x4 x = xq[j] + (f32x4){__uint_as_float(dq[j].x << 16), __uint_as_float(dq[j].x & 0xffff0000u), __uint_as_float(dq[j].y << 16), __uint_as_float(dq[j].y & 0xffff0000u)};
          ss += x[0] * x[0] + x[1] * x[1] + x[2] * x[2] + x[3] * x[3];
          const f32x4 xg = x * g;
          *(f32x4*)(xs + tok_s * XSTR + j * 32 + seg * 4) = xg;
          u32x2 w; w.x = cvt_pk_bf16(xg[0], xg[1]); w.y = cvt_pk_bf16(xg[2], xg[3]); *(u32x2*)(hr + j * 32) = w; }
#pragma unroll
        for (int i = 0; i < 6; ++i) *(f32x4*)(wsm + (tid + i * NTHR) * 4) = wq[i]; }
      if (kc < 3) {
#pragma unroll
        for (int j = 0; j < 8; ++j) { xq[j] = __builtin_nontemporal_load((const f32x4*)(xrow + (kc + 1) * 256 + j * 32)); dq[j] = ld8(gws, drow + (kc + 1) * 256 + j * 32); }
#pragma unroll
        for (int i = 0; i < 6; ++i) wq[i] = ld16f(gws, wrp + (kc + 1) * 3072 + i * NTHR); }
      __syncthreads();
      { const float* ap = xs + (16 * mt + fr) * XSTR + fq; const float* bp = wsm + fq * 48 + fr + (heavy ? 0 : 32);
        if (heavy) {
#pragma unroll 8
          for (int ks = 0; ks < 64; ++ks) { const float a = ap[4 * ks]; const float b0 = bp[ks * 192], b1 = bp[ks * 192 + 16];
            acc0 = __builtin_amdgcn_mfma_f32_16x16x4f32(a, b0, acc0, 0, 0, 0); acc1 = __builtin_amdgcn_mfma_f32_16x16x4f32(a, b1, acc1, 0, 0, 0); }
        } else {
#pragma unroll 8
          for (int ks = 0; ks < 64; ++ks) { const float a = ap[4 * ks]; const float b2 = bp[ks * 192];
            acc0 = __builtin_amdgcn_mfma_f32_16x16x4f32(a, b2, acc0, 0, 0, 0); }
        } }
    }
    ss = sum8(ss);
    if (seg == 0) { const float rs = __builtin_amdgcn_rsqf(ss * (1.f / D) + 1e-6f); rsm[tok_s] = rs; RSG[tok0 + tok_s] = rs; }
    __syncthreads();
    { const int o0 = heavy ? fr : 32 + fr;
#pragma unroll
      for (int rg = 0; rg < 4; ++rg) { const int tk = 16 * mt + 4 * fq + rg; const float rs = rsm[tk];
        if (heavy) { lgm[tk * 48 + fr] = acc0[rg] * rs + b_re[fr]; lgm[tk * 48 + 16 + fr] = acc1[rg] * rs + b_re[16 + fr]; }
        else if (fr < 4) lgm[tk * 48 + o0] = acc0[rg] * rs + b_rg[fr]; } }
    __syncthreads();
    if (tid < 64) {
      const int tok = tok0 + tid; const float* gl = lgm + tid * 48 + 32;
      int gs = 0; float gm = gl[0];
      for (int o = 1; o < 4; ++o) if (gl[o] > gm) { gm = gl[o]; gs = o; }
      float den = 0.f; for (int o = 0; o < 4; ++o) den += __expf(gl[o] - gm);
      const float pg = 1.f / den;
      const float* e = lgm + tid * 48 + gs * 8;
      int i0 = 0; float v0 = e[0];
      for (int o = 1; o < 8; ++o) if (e[o] > v0) { v0 = e[o]; i0 = o; }
      int i1 = -1; float v1 = -3.0e38f;
      for (int o = 0; o < 8; ++o) if (o != i0 && e[o] > v1) { v1 = e[o]; i1 = o; }
      const float w0 = 1.f / (1.f + __expf(v1 - v0));
      const int e0 = gs * 8 + i0, e1 = gs * 8 + i1;
      EID[tok * 2] = e0; EID[tok * 2 + 1] = e1;
      EW[tok * 2] = pg * w0; EW[tok * 2 + 1] = pg * (1.f - w0);
      const int r0 = atomicAdd(&CNT[e0], 1), r1 = atomicAdd(&CNT[e1], 1);
      RANK[tok * 2] = r0; RANK[tok * 2 + 1] = r1;
      const float rs = rsm[tid];
      int* LTOK = (int*)(P.ws + WS_LTOK); float* LW = (float*)(P.ws + WS_LW); float* LRS = (float*)(P.ws + WS_LRS);
      const size_t j0 = (size_t)e0 * NTOK + r0, j1 = (size_t)e1 * NTOK + r1;
      LTOK[j0] = tok; LW[j0] = pg * w0; LRS[j0] = rs; LTOK[j1] = tok; LW[j1] = pg * (1.f - w0); LRS[j1] = rs;
    }
  }
}

__device__ void build_rtoff(const Params& P, LAS int* rtoff) {
  __syncthreads();
  if (threadIdx.x == 0) { const int* CNT = (const int*)(P.ws + WS_CNT); int acc = 0;
    for (int l = 0; l < 64; ++l) { const int c = __hip_atomic_load(&CNT[l], __ATOMIC_RELAXED, __HIP_MEMORY_SCOPE_AGENT); rtoff[l] = acc; rtoff[65 + l] = c; acc += (c + 255) >> 8; }
    rtoff[64] = acc; }
  __syncthreads();
  if (threadIdx.x < MAXRT) { const int rt = threadIdx.x; int l = 0; while (l < 63 && rtoff[l + 1] <= rt) ++l; rtoff[136 + rt] = l; }
  __syncthreads();
}

__device__ void phase_combine(const Params& P, const LAS int* rtoff) {
  const GB gws = GB_WS(P), gout = GB_OUT(P);
  const bf16_t* O = (const bf16_t*)(P.ws + WS_O); const bf16_t* DL = (const bf16_t*)(P.ws + WS_DELTA); const int* EID = (const int*)(P.ws + WS_EID); const int* RANK = (const int*)(P.ws + WS_RANK);
  int tid_ = threadIdx.x; asm volatile("" : "+v"(tid_));
  const int lane = tid_ & 63, gw = blockIdx.x * 8 + (tid_ >> 6), ngw = gridDim.x * 8;
  struct Rows { u32x4 a0, a1, b0, b1, d0, d1; f32x4 x[4]; };
  const int ntk = (NTOK - gw + ngw - 1) / ngw;
  for (int j0 = 0; j0 < ntk; j0 += 32) {
    int myrow = 0;
    { const int jt = j0 + (lane >> 1), tk = gw + jt * ngw;
      if (jt < ntk) myrow = rtoff[ld4i(gws, EID + tk * 2 + (lane & 1))] * 256 + ld4i(gws, RANK + tk * 2 + (lane & 1)); }
    const int nj = (ntk - j0) < 32 ? (ntk - j0) : 32;
    Rows cur, nxt;
#define CMB_LOAD(R, JJ) do { const int tk_ = gw + (j0 + (JJ)) * ngw; const int r0_ = __shfl(myrow, 2 * (JJ)), r1_ = __shfl(myrow, 2 * (JJ) + 1); \
      R.a0 = ld16(gws, O + (size_t)r0_ * D + lane * 16); R.a1 = ld16(gws, O + (size_t)r0_ * D + lane * 16 + 8); \
      R.b0 = ld16(gws, O + (size_t)r1_ * D + lane * 16); R.b1 = ld16(gws, O + (size_t)r1_ * D + lane * 16 + 8); \
      R.d0 = ld16(gws, DL + (size_t)tk_ * D + lane * 16); R.d1 = ld16(gws, DL + (size_t)tk_ * D + lane * 16 + 8); \
      _Pragma("unroll") for (int q_ = 0; q_ < 4; ++q_) R.x[q_] = __builtin_nontemporal_load((const f32x4*)(P.in[0] + (size_t)tk_ * D + lane * 16 + 4 * q_)); } while (0)
    CMB_LOAD(cur, 0);
    for (int jj = 0; jj < nj; ++jj) {
      if (jj + 1 < nj) CMB_LOAD(nxt, jj + 1);
      float fa[16], fb[16], fd[16];
      { float t[8]; unpack8f(cur.d0, t);
#pragma unroll
        for (int q = 0; q < 8; ++q) fd[q] = t[q];
        unpack8f(cur.d1, t);
#pragma unroll
        for (int q = 0; q < 8; ++q) fd[8 + q] = t[q];
        unpack8f(cur.a0, t);
#pragma unroll
        for (int q = 0; q < 8; ++q) fa[q] = t[q];
        unpack8f(cur.a1, t);
#pragma unroll
        for (int q = 0; q < 8; ++q) fa[8 + q] = t[q];
        unpack8f(cur.b0, t);
#pragma unroll
        for (int q = 0; q < 8; ++q) fb[q] = t[q];
        unpack8f(cur.b1, t);
#pragma unroll
        for (int q = 0; q < 8; ++q) fb[8 + q] = t[q]; }
      float* op = P.out + (size_t)(gw + (j0 + jj) * ngw) * D + lane * 16;
#pragma unroll
      for (int q4 = 0; q4 < 4; ++q4) { f32x4 o;
#pragma unroll
        for (int q = 0; q < 4; ++q) o[q] = ((cur.x[q4][q] + fd[4 * q4 + q]) + fa[4 * q4 + q]) + fb[4 * q4 + q];
        *(f32x4*)(op + 4 * q4) = o; }
      cur = nxt;
    }
#undef CMB_LOAD
  }
}

__global__ void __launch_bounds__(NTHR, 2) fwd_megakernel(Params P) {
  extern __shared__ __attribute__((aligned(16))) unsigned char lds[];
  float* sm = (float*)lds;
  LAS unsigned char* ldsl = (LAS unsigned char*)lds;
  LAS int* rtoff = (LAS int*)(ldsl + pg8::STAGE_BYTES);
  if (threadIdx.x < 4) ((LAS unsigned*)(ldsl + 147440))[threadIdx.x] = 0u;
  __syncthreads();
  (void)xcd_barrier_post((unsigned*)(P.ws + WS_BAR), (volatile LAS unsigned*)(ldsl + 147440));
#define GRID_BARRIER() do { XcdBarrier xb_; xb_.bar = (unsigned*)(P.ws + WS_BAR); xb_.x = 0u; xb_.st = (volatile LAS unsigned*)(ldsl + 147440); xcd_barrier(xb_); } while (0)
  const int G = gridDim.x, bx = blockIdx.x;
  const int vcu = (G % 8 == 0) ? (bx % 8) * (G / 8) + bx / 8 : bx;

  phase_prologue(P, sm);     GRID_BARRIER();
  { pg8::Gemm g{(const bf16_t*)(P.ws + WS_H), (const bf16_t*)(P.ws + WS_W1T), D}; pg8::StaticOrder S; S.init(NTOK, INCP, G, bx);
    EpiP E{(bf16_t*)(P.ws + WS_P), P.in[22], P.ws + WS_G8};
    pg8::gemm_phase(ldsl, g, S, E); }
  GRID_BARRIER();
  phase_scan(P, ldsl);
  phase_na(P, ldsl, G, vcu); GRID_BARRIER();
  phase_rwkv_post(P, ldsl);  GRID_BARRIER();
  { pg8::StaticOrder S; S.init(NTOK, D, G, bx);
    pg8::Gemm g{(const bf16_t*)(P.ws + WS_RY), (const bf16_t*)(P.ws + WS_WOA), D};
    EpiMix E{P.ws + WS_G8, (bf16_t*)(P.ws + WS_MIX), GB_WS(P)};
    pg8::gemm_phase(ldsl, g, S, E); }
  GRID_BARRIER();
  { pg8::StaticOrder S; S.init(NTOK, D, G, bx);
    pg8::Gemm g{(const bf16_t*)(P.ws + WS_MIX), (const bf16_t*)(P.ws + WS_WOUT), D};
    EpiXout E{(bf16_t*)(P.ws + WS_DELTA)};
    pg8::gemm_phase(ldsl, g, S, E); }
  GRID_BARRIER();
  phase_router(P, sm);       GRID_BARRIER();
  build_rtoff(P, rtoff);
  { pg8::MoeOrder S{rtoff, 0, rtoff[64], 2, G, vcu, (const int*)(P.ws + WS_LTOK), GB_WS(P)};
    pg8::Gemm g{(const bf16_t*)P.out, (const bf16_t*)(P.ws + WS_WGU), D};
    EpiGateUp E{(bf16_t*)(P.ws + WS_HE), (const float*)(P.ws + WS_LRS), GB_WS(P)};
    pg8::gemm_phase<true>(ldsl, g, S, E); }
  GRID_BARRIER();
  { pg8::MoeOrder S{rtoff, 0, rtoff[64], 4, G, vcu, (const int*)(P.ws + WS_LTOK), GB_WS(P)};
    pg8::Gemm g{(const bf16_t*)(P.ws + WS_HE), (const bf16_t*)(P.ws + WS_WD), 256};
    EpiDown E{(const float*)(P.ws + WS_LW), (bf16_t*)(P.ws + WS_O), GB_WS(P)};
    pg8::gemm_phase(ldsl, g, S, E); }
  GRID_BARRIER();
  phase_combine(P, rtoff);
}

extern "C" void kernel_launch(void* const* d_in, const int* in_sizes, int n_in, void* d_out, int out_size,
                              void* d_ws, size_t ws_size, hipStream_t stream) {
  constexpr size_t kDynLds = 144 * 1024;
  static int grid_blocks = 0;
  if (!grid_blocks) {
    int dev = 0, cus = 0, per_cu = 0;
    (void)hipGetDevice(&dev);
    (void)hipDeviceGetAttribute(&cus, hipDeviceAttributeMultiprocessorCount, dev);
    (void)hipFuncSetAttribute((const void*)fwd_megakernel, hipFuncAttributeMaxDynamicSharedMemorySize, (int)kDynLds);
    (void)hipOccupancyMaxActiveBlocksPerMultiprocessor(&per_cu, fwd_megakernel, NTHR, kDynLds);
    if (n_in != 34 || out_size != NTOK * D || ws_size < WS_NEED || per_cu < 1) {
      fprintf(stderr, "kernel_launch: unexpected n_in %d out_size %d ws_size %zu per_cu %d\n", n_in, out_size, ws_size, per_cu);
      grid_blocks = -1; return;
    }
    grid_blocks = cus;
  }
  if (grid_blocks < 0) return;
  (void)hipMemsetAsync((unsigned char*)d_ws + WS_BAR, 0, XCD_BAR_WORDS * 4, stream);
  Params p{};
  for (int i = 0; i < 34; ++i) p.in[i] = (const float*)d_in[i];
  p.out = (float*)d_out; p.ws = (unsigned char*)d_ws;
  void* args[] = {&p};
  hipError_t e = hipLaunchCooperativeKernel((void*)fwd_megakernel, dim3(grid_blocks), dim3(NTHR), args, kDynLds, stream);
  if (e != hipSuccess) fprintf(stderr, "cooperative launch failed: %s (grid %d)\n", hipGetErrorString(e), grid_blocks);
}
```

```cpp
#include <hip/hip_runtime.h>
#include <hip/hip_cooperative_groups.h>
#include <cstdio>
#include <cstdint>
namespace cg = cooperative_groups;

#define LAS __attribute__((address_space(3)))
typedef unsigned short bf16_t;
typedef short bf16x8 __attribute__((ext_vector_type(8)));
typedef float f32x4 __attribute__((ext_vector_type(4)));
typedef unsigned u32x4 __attribute__((ext_vector_type(4)));
typedef unsigned u32x2 __attribute__((ext_vector_type(2)));

__device__ __forceinline__ float bf2f(bf16_t b) { return __uint_as_float(((unsigned)b) << 16); }
__device__ __forceinline__ bf16_t f2bf(float f) { unsigned u = __float_as_uint(f); u += 0x7FFFu + ((u >> 16) & 1u); return (bf16_t)(u >> 16); }
typedef __bf16 bf16x2_t __attribute__((ext_vector_type(2)));
typedef float f32x2 __attribute__((ext_vector_type(2)));
__device__ __forceinline__ unsigned cvt_pk_bf16(float lo, float hi) { const f32x2 v = {lo, hi}; return __builtin_bit_cast(unsigned, __builtin_convertvector(v, bf16x2_t)); }
typedef short s16x4 __attribute__((ext_vector_type(4)));
__device__ __forceinline__ void unpack8f(const u32x4 w, float (&f)[8]) {
  f[0] = __uint_as_float(w.x << 16); f[1] = __uint_as_float(w.x & 0xffff0000u); f[2] = __uint_as_float(w.y << 16); f[3] = __uint_as_float(w.y & 0xffff0000u);
  f[4] = __uint_as_float(w.z << 16); f[5] = __uint_as_float(w.z & 0xffff0000u); f[6] = __uint_as_float(w.w << 16); f[7] = __uint_as_float(w.w & 0xffff0000u);
}
struct GB { __amdgpu_buffer_rsrc_t r; const char* base; };
__device__ __forceinline__ GB mkgb(const void* base, unsigned bytes) { GB g; g.r = __builtin_amdgcn_make_buffer_rsrc((void*)base, 0, bytes, 0x00020000); g.base = (const char*)base; return g; }
__device__ __forceinline__ u32x4 ld16(const GB& g, const void* p) { return __builtin_amdgcn_raw_buffer_load_b128(g.r, (int)((const char*)p - g.base), 0, 16); }
__device__ __forceinline__ f32x4 ld16f(const GB& g, const void* p) { return __builtin_bit_cast(f32x4, ld16(g, p)); }
__device__ __forceinline__ u32x2 ld8(const GB& g, const void* p) { return __builtin_amdgcn_raw_buffer_load_b64(g.r, (int)((const char*)p - g.base), 0, 16); }
__device__ __forceinline__ float ld4f(const GB& g, const float* p) { return __uint_as_float(__builtin_amdgcn_raw_buffer_load_b32(g.r, (int)((const char*)p - g.base), 0, 16)); }
__device__ __forceinline__ int ld4i(const GB& g, const int* p) { return (int)__builtin_amdgcn_raw_buffer_load_b32(g.r, (int)((const char*)p - g.base), 0, 16); }
#define GB_WS(P) mkgb((P).ws, 0x20000000u)
#define GB_OUT(P) mkgb((P).out, 0x08000000u)
__device__ __forceinline__ float sigmoidf_(float x) { return __builtin_amdgcn_rcpf(1.f + __expf(-x)); }
template <int CTRL> __device__ __forceinline__ float dpp_f(float x) { return __builtin_bit_cast(float, __builtin_amdgcn_update_dpp(0, __builtin_bit_cast(int, x), CTRL, 0xF, 0xF, true)); }
__device__ __forceinline__ float sum4(float x) { x += dpp_f<0xB1>(x); x += dpp_f<0x4E>(x); return x; }
__device__ __forceinline__ float sum8(float x) { x = sum4(x); x += dpp_f<0x141>(x); return x; }
__device__ __forceinline__ float sum16(float x) { x = sum8(x); x += dpp_f<0x140>(x); return x; }
__device__ __forceinline__ float sum16x4(const float (&x)[4], int fr) {
  const bool o1 = (fr & 1) != 0, o2 = (fr & 2) != 0;
  const float s01 = (o1 ? x[1] : x[0]) + dpp_f<0xB1>(o1 ? x[0] : x[1]);
  const float s23 = (o1 ? x[3] : x[2]) + dpp_f<0xB1>(o1 ? x[2] : x[3]);
  float t = (o2 ? s23 : s01) + dpp_f<0x4E>(o2 ? s01 : s23);
  t += dpp_f<0x124>(t); t += dpp_f<0x128>(t);
  return t;
}
__device__ __forceinline__ s16x4 lds_tr16(LAS unsigned char* lds, int byte_off) { return __builtin_amdgcn_ds_read_tr16_b64_v4i16((LAS s16x4*)(lds + byte_off)); }
__device__ __forceinline__ float wave_sum(float v) { v = sum16(v); v += __shfl_xor(v, 16); v += __shfl_xor(v, 32); return v; }
__device__ __forceinline__ float wave_max(float v) {
#pragma unroll
  for (int o = 32; o > 0; o >>= 1) v = fmaxf(v, __shfl_xor(v, o));
  return v;
}

constexpr int NB = 16, T = 2048, D = 1024, NTOK = NB * T;
constexpr int INC = 5504, INCP = 5632, C_R = 0, C_K = 512, C_V = 1024, C_WL = 1536, C_AL = 1664, C_GL = 1792, C_Q = 1920, C_NK = 2432, C_NV = 2944, C_G = 3456;
constexpr int NTHR = 512;
constexpr int MAXRT = 320;
constexpr size_t MiB = 1024 * 1024;
constexpr size_t WS_P = 0;
constexpr size_t WS_G8 = 216 * MiB;
constexpr size_t WS_H = 344 * MiB;
constexpr size_t WS_RY = WS_H;
constexpr size_t WS_NY = WS_H + 1024;
constexpr size_t WS_SD = 408 * MiB;
constexpr size_t WS_MIX = 410 * MiB;
constexpr size_t WS_VBLK = WS_MIX;
constexpr size_t WS_GUPT = 493 * MiB;
constexpr size_t WS_EID = 474 * MiB;
constexpr size_t WS_EW = WS_EID + 256 * 1024;
constexpr size_t WS_RANK = WS_EW + 256 * 1024;
constexpr size_t WS_CNT = WS_RANK + 256 * 1024;
constexpr size_t WS_BAR = WS_CNT + 4096;
constexpr size_t WS_RSG = WS_CNT + 65536;
constexpr size_t WS_TOKS = 476 * MiB;
constexpr size_t WS_WTS = WS_TOKS + 512 * 1024;
constexpr size_t WS_RSS = WS_TOKS + 1024 * 1024;
constexpr size_t WS_W1T = 478 * MiB;
constexpr size_t WS_WOA = 489 * MiB;
constexpr size_t WS_WOB = 490 * MiB;
constexpr size_t WS_WOUT = 491 * MiB;
constexpr size_t WS_WR = 493 * MiB + 512 * 1024;
constexpr size_t WS_NEED = 494 * MiB;
constexpr size_t WS_DELTA = 0;
constexpr size_t WS_LTOK = 64 * MiB;
constexpr size_t WS_LW = 72 * MiB;
constexpr size_t WS_LRS = 80 * MiB;
constexpr size_t WS_HE = 328 * MiB;
constexpr size_t WS_WGU = 280 * MiB;
constexpr size_t WS_WD = 312 * MiB;
constexpr size_t WS_O = 88 * MiB;

struct Params { const float* in[34]; float* out; unsigned char* ws; };

#define XB_TMO      128
#define XB_XCNT(j)  (256  + 64 * (j))
#define XB_XSUB(j)  (1280 + 64 * (j))
#define XB_XGEN(j)  (2304 + 64 * (j))
#define XB_TOP      3328
#define XB_TOPGEN   3392
#define XCD_BAR_WORDS 3456
#define XB_SPIN_CAP (1u << 22)
__device__ __forceinline__ unsigned xb_ld(unsigned* p)              { return __hip_atomic_load(p, __ATOMIC_RELAXED, __HIP_MEMORY_SCOPE_AGENT); }
__device__ __forceinline__ unsigned xb_add(unsigned* p, unsigned v) { return __hip_atomic_fetch_add(p, v, __ATOMIC_RELAXED, __HIP_MEMORY_SCOPE_AGENT); }
__device__ __forceinline__ unsigned xb_xcc_id() { return (unsigned)__builtin_amdgcn_s_getreg((3 << 11) | 20) & 0xFu; }
#define XB_SPIN(cond, bar) do { unsigned _sp = 0; while (cond) { __builtin_amdgcn_s_sleep(1); \
    if ((++_sp & 255u) == 0u) { if (xb_ld(&(bar)[XB_TMO])) break; if (_sp > XB_SPIN_CAP) { atomicAdd(&(bar)[XB_TMO], 1u); break; } } } } while (0)
struct XcdBarrier { unsigned* bar; unsigned x; volatile LAS unsigned* st; };
__device__ __forceinline__ XcdBarrier xcd_barrier_post(unsigned* bar, volatile LAS unsigned* st) {
  XcdBarrier b; b.bar = bar; b.x = xb_xcc_id(); b.st = st;
  if (threadIdx.x == 0) (void)xb_add(&bar[XB_XCNT(b.x)], 1u);
  return b;
}
__device__ __forceinline__ void xcd_barrier_complete(unsigned* bar, unsigned x, unsigned& nloc, unsigned& nx) {
  const unsigned G = gridDim.x * gridDim.y * gridDim.z;
  unsigned sum, cnt, mine, sp = 0u;
  for (;;) {
    sum = 0u; cnt = 0u; mine = 0u;
#pragma unroll
    for (unsigned j = 0; j < 16; ++j) { const unsigned c = xb_ld(&bar[XB_XCNT(j)]); sum += c; cnt += (c > 0u) ? 1u : 0u; mine = (j == x) ? c : mine; }
    if (sum == G) break;
    __builtin_amdgcn_s_sleep(1);
    if ((++sp & 255u) == 0u) { if (xb_ld(&bar[XB_TMO])) break; if (sp > XB_SPIN_CAP) { atomicAdd(&bar[XB_TMO], 1u); break; } }
  }
  nloc = mine > 0u ? mine : 1u; nx = cnt > 0u ? cnt : 1u;
}
__device__ __forceinline__ void xcd_barrier(const XcdBarrier& b) {
  asm volatile("s_waitcnt vmcnt(0)" ::: "memory");
  __syncthreads();
  if (threadIdx.x == 0) {
    unsigned* bar = b.bar; const unsigned bx_ = xb_xcc_id();
    __builtin_amdgcn_s_waitcnt(0);
    unsigned nloc = b.st[0], nx = b.st[1];
    if (nloc == 0u) { xcd_barrier_complete(bar, bx_, nloc, nx); b.st[0] = nloc; b.st[1] = nx; }
    const unsigned old = xb_add(&bar[XB_XSUB(bx_)], 1u);
    const unsigned gen = old / nloc;
    if (old + 1u == (gen + 1u) * nloc) {
      __builtin_amdgcn_fence(__ATOMIC_RELEASE, "agent");
      asm volatile("s_waitcnt vmcnt(0)" ::: "memory");
      const unsigned og = xb_add(&bar[XB_TOP], 1u);
      const unsigned tg = og / nx;
      if (og + 1u == (tg + 1u) * nx) xb_add(&bar[XB_TOPGEN], 1u);
      else XB_SPIN(xb_ld(&bar[XB_TOPGEN]) == tg, bar);
      __builtin_amdgcn_fence(__ATOMIC_ACQUIRE, "agent");
      xb_add(&bar[XB_XGEN(bx_)], 1u);
      asm volatile("s_waitcnt vmcnt(0)" ::: "memory");
    } else {
      XB_SPIN(xb_ld(&bar[XB_XGEN(bx_)]) == gen, bar);
      __builtin_amdgcn_fence(__ATOMIC_ACQUIRE, "agent");
      asm volatile("s_waitcnt vmcnt(0)" ::: "memory");
    }
  }
  __syncthreads();
}

namespace pg8 {
#define PG8_AUX_A 16
#define PG8_AUX_B 16
constexpr int BM = 256, BK = 64, HALF = 128, HTB = HALF * BK * 2, STAGE_BYTES = 8 * HTB, NXCD = 8, WGM = 8;
__host__ __device__ __forceinline__ int lds_byte(int r, int c) { const int st = (r >> 4) * 2 + (c >> 5), rr = r & 15, cc = c & 31, ob = rr * 64 + cc * 2; return st * 1024 + (ob ^ (((ob >> 9) & 1) << 5)); }
__host__ __device__ __forceinline__ void stage_rc(int b, int& R, int& C) { const int st = b / 1024, sb = b % 1024, swz = sb ^ (((sb >> 9) & 1) << 5); R = (st >> 1) * 16 + swz / 64; C = (st & 1) * 32 + (swz % 64) / 2; }
__host__ __device__ __forceinline__ int perm32(int rho) { const int n = rho >> 4, i = rho & 15; return 8 * (i >> 2) + 4 * n + (i & 3); }

struct Unit { int pm, pn, l, r0; };
struct Gemm { const bf16_t* A; const bf16_t* Bt; int K; };

struct StaticOrder {
  int nM, nN, nwg, G, c;
  __device__ void init(int M, int N, int G_, int c_) { nM = M / BM; nN = N / BM; nwg = nM * nN; G = G_; c = c_; }
  __device__ bool next(int i, Unit& u) const {
    const long L = (long)i * G + c; if (L >= nwg) return false;
    int wgid = (int)L; { const int q = nwg / NXCD, r = nwg % NXCD, xcd = wgid % NXCD, off = wgid / NXCD; wgid = (xcd < r ? xcd * (q + 1) : r * (q + 1) + (xcd - r) * q) + off; }
    const int nig = WGM * nN, gid = wgid / nig, fm = gid * WGM, gsz = (nM - fm) < WGM ? (nM - fm) : WGM;
    u.pm = fm + ((wgid % nig) % gsz); u.pn = (wgid % nig) / gsz; u.l = 0; u.r0 = 0; return true;
  }
};
struct MoeOrder {
  const LAS int* rtoff;
  int rt0, nrt, nct, G, v;
  __device__ bool next(int i, Unit& u) const {
    const int L = i * G + v; if (L >= nrt * nct) return false;
    const int rt = rt0 + L / nct, ct = L % nct;
    const int l = rtoff[136 + rt];
    u.pm = rt; u.pn = (l & 31) * nct + ct; u.l = l; u.r0 = (rt - rtoff[l]) * 256; return true;
  }
  const int* ltok;
  GB gw;
  __device__ __forceinline__ int a_row(const Unit& u, int r) const { const int rr = u.r0 + r; return rr < rtoff[65 + u.l] ? ld4i(gw, ltok + (size_t)u.l * NTOK + rr) : 0; }
};

template <bool GATHER = false, class Epi, class Sched>
__device__ __forceinline__ void gemm_phase(LAS unsigned char* lds, const Gemm g, const Sched& S, const Epi& E) {
  int tid_ = threadIdx.x; asm volatile("" : "+v"(tid_));
  const int tid = tid_, wid = __builtin_amdgcn_readfirstlane(tid >> 6), lane = tid & 63, wr = wid >> 2, wc = wid & 3, fr = lane & 15, fq = lane >> 4;
  const int K = g.K, nt = K / BK;
  unsigned voffA[2], voffB[2];
#pragma unroll
  for (int i = 0; i < 2; ++i) { int R, C; stage_rc(tid * 16 + i * 8192, R, C); const int Rb = Epi::PERM ? ((R & ~31) + perm32(R & 31)) : R;
    voffA[i] = (unsigned)(R * K + C) * 2u; voffB[i] = (unsigned)(Rb * K + C) * 2u; }
  unsigned vAc[2][2], vAn[2][2];
#define PG8_AROWS(dst, u) do { if constexpr (GATHER) { int _t = threadIdx.x; asm volatile("" : "+v"(_t)); _Pragma("unroll") for (int _i = 0; _i < 2; ++_i) { int _R, _C; stage_rc(_t * 16 + _i * 8192, _R, _C); \
    _Pragma("unroll") for (int _h = 0; _h < 2; ++_h) dst[_h][_i] = ((unsigned)S.a_row(u, _h * HALF + _R) * (unsigned)K + (unsigned)_C) * 2u; } } } while (0)
  const size_t kstep = (size_t)(BK * 2);
  const size_t hstep = (size_t)HALF * K * 2;
  const size_t tstep = 2 * hstep;
  const unsigned ldsw = (unsigned)wid * 1024u;
  const int aoff = lds_byte(wr * 64 + fr, fq * 8), boff = lds_byte(wc * 32 + fr, fq * 8);
#define PG8_SA(b, h) (((b) * 2 + (h)) * HTB)
#define PG8_SB(b, h) ((4 + (b) * 2 + (h)) * HTB)
#define PG8_STAGE_X(bufoff, gbase, voff, AUX) do { _Pragma("unroll") for (int _i = 0; _i < 2; ++_i) \
    __builtin_amdgcn_global_load_lds((const unsigned*)((const char*)(gbase) + (voff)[_i]), (LAS unsigned*)(lds + (bufoff) + ldsw + _i * 8192), 16, 0, AUX); } while (0)
#define PG8_STAGE(bufoff, gbase, voff) PG8_STAGE_X(bufoff, gbase, voff, PG8_AUX_B)
#define PG8_STAGE_A(bufoff, gbase, h, nx) do { if constexpr (GATHER) { _Pragma("unroll") for (int _i = 0; _i < 2; ++_i) \
      __builtin_amdgcn_global_load_lds((const unsigned*)((const char*)(gbase) + ((nx) ? vAn[h][_i] : vAc[h][_i])), (LAS unsigned*)(lds + (bufoff) + ldsw + _i * 8192), 16, 0, PG8_AUX_A); } \
    else { PG8_STAGE_X(bufoff, (const char*)(gbase) + ((h) ? hstep : 0), voffA, PG8_AUX_A); } } while (0)
#define PG8_LDA(dst, b, h) do { _Pragma("unroll") for (int m = 0; m < 4; ++m) _Pragma("unroll") for (int k = 0; k < 2; ++k) dst[m][k] = *(const LAS bf16x8*)(lds + PG8_SA(b, h) + aoff + m * 2048 + k * 1024); } while (0)
#define PG8_LDB(dst, b, h) do { _Pragma("unroll") for (int n = 0; n < 2; ++n) _Pragma("unroll") for (int k = 0; k < 2; ++k) dst[n][k] = *(const LAS bf16x8*)(lds + PG8_SB(b, h) + boff + n * 2048 + k * 1024); } while (0)
#define PG8_MMA(ai, bj, At, Bt) do { __builtin_amdgcn_s_setprio(1); _Pragma("unroll") for (int m = 0; m < 4; ++m) _Pragma("unroll") for (int n = 0; n < 2; ++n) _Pragma("unroll") for (int k = 0; k < 2; ++k) \
    acc[ai][bj][m][n] = __builtin_amdgcn_mfma_f32_16x16x32_bf16(Bt[n][k], At[m][k], acc[ai][bj][m][n], 0, 0, 0); __builtin_amdgcn_s_setprio(0); } while (0)
#define PG8_WAIT_V(n) asm volatile("s_waitcnt vmcnt(" #n ")" ::: "memory")
#define PG8_WAIT_L(n) asm volatile("s_waitcnt lgkmcnt(" #n ")" ::: "memory")
#define PG8_BAR __builtin_amdgcn_s_barrier()
#define PG8_SCHED __builtin_amdgcn_sched_barrier(0)
  Unit cur, nxt; int ui = 0;
  if (!S.next(0, cur)) return;
  f32x4 acc[2][2][4][2];
#pragma unroll
  for (int a = 0; a < 2; ++a)
#pragma unroll
    for (int b = 0; b < 2; ++b)
#pragma unroll
      for (int m = 0; m < 4; ++m)
#pragma unroll
        for (int n = 0; n < 2; ++n) acc[a][b][m][n] = (f32x4){0.f, 0.f, 0.f, 0.f};
  bf16x8 At[4][2], B0[2][2], B1[2][2];
  const char* cA = (const char*)g.A + (GATHER ? (size_t)0 : (size_t)cur.pm * tstep); const char* cB = (const char*)g.Bt + (size_t)cur.pn * tstep;
  PG8_AROWS(vAc, cur);
#pragma unroll
  for (int _h = 0; _h < 2; ++_h)
#pragma unroll
    for (int _i = 0; _i < 2; ++_i) vAn[_h][_i] = vAc[_h][_i];
  PG8_STAGE(PG8_SB(0, 0), cB, voffB); PG8_STAGE_A(PG8_SA(0, 0), cA, 0, false); PG8_STAGE(PG8_SB(0, 1), cB + hstep, voffB); PG8_STAGE_A(PG8_SA(0, 1), cA, 1, false);
  if (wr == 1) PG8_BAR;
  PG8_WAIT_V(4); PG8_BAR;
  PG8_STAGE(PG8_SB(1, 0), cB + kstep, voffB); PG8_STAGE_A(PG8_SA(1, 0), cA + kstep, 0, false); PG8_STAGE(PG8_SB(1, 1), cB + hstep + kstep, voffB);
  PG8_WAIT_V(6); PG8_BAR;
  for (;;) {
    const bool has_next = S.next(ui + 1, nxt);
    const char* nA = has_next ? (const char*)g.A + (GATHER ? (size_t)0 : (size_t)nxt.pm * tstep) : cA; const char* nB = has_next ? (const char*)g.Bt + (size_t)nxt.pn * tstep : cB;
    if (has_next) PG8_AROWS(vAn, nxt);
    float pre[8];
    if constexpr (Epi::PRE) { int fr_ = fr; asm volatile("" : "+v"(fr_)); E.preload(cur, wr, fr_, pre); }
    for (int t = 0; t < nt; t += 2) {
      if constexpr (Epi::MID) { int mid_ = __builtin_amdgcn_readfirstlane(2 * t == nt); asm volatile("" : "+s"(mid_));
        if (mid_) { int fr_ = fr, fq_ = fq; asm volatile("" : "+v"(fr_), "+v"(fq_)); E.mid(acc, cur, wr, wc, fr_, fq_); } }
      const bool last = (t == nt - 2);
      const char* a1 = cA + (size_t)(t + 1) * kstep;
      const char* a2 = last ? nA : cA + (size_t)(t + 2) * kstep; const char* b2 = last ? nB : cB + (size_t)(t + 2) * kstep;
      const char* a3 = a2 + kstep; const char* b3 = b2 + kstep;
      PG8_LDB(B0, 0, 0); PG8_SCHED; PG8_LDA(At, 0, 0); PG8_STAGE_A(PG8_SA(1, 1), a1, 1, false);
      PG8_WAIT_L(8); PG8_BAR; PG8_WAIT_L(0); PG8_MMA(0, 0, At, B0); PG8_BAR; PG8_SCHED;
      PG8_LDB(B1, 0, 1); PG8_STAGE(PG8_SB(0, 0), b2, voffB);
      PG8_BAR; PG8_WAIT_L(0); PG8_MMA(0, 1, At, B1); PG8_BAR;
      PG8_LDA(At, 0, 1); PG8_STAGE_A(PG8_SA(0, 0), a2, 0, last);
      PG8_BAR; PG8_WAIT_L(0); PG8_MMA(1, 0, At, B0); PG8_BAR; PG8_SCHED;
      PG8_STAGE(PG8_SB(0, 1), b2 + hstep, voffB);
      PG8_WAIT_V(6); PG8_BAR; PG8_MMA(1, 1, At, B1); PG8_BAR;
      PG8_LDB(B0, 1, 0); PG8_SCHED; PG8_LDA(At, 1, 0); PG8_STAGE_A(PG8_SA(0, 1), a2, 1, last);
      PG8_WAIT_L(8); PG8_BAR; PG8_WAIT_L(0); PG8_MMA(0, 0, At, B0); PG8_BAR; PG8_SCHED;
      PG8_LDB(B1, 1, 1); PG8_STAGE(PG8_SB(1, 0), b3, voffB);
      PG8_BAR; PG8_WAIT_L(0); PG8_MMA(0, 1, At, B1); PG8_BAR;
      PG8_LDA(At, 1, 1); PG8_STAGE_A(PG8_SA(1, 0), a3, 0, last);
      PG8_BAR; PG8_WAIT_L(0); PG8_MMA(1, 0, At, B0); PG8_BAR; PG8_SCHED;
      PG8_STAGE(PG8_SB(1, 1), b3 + hstep, voffB);
      PG8_WAIT_V(6); PG8_BAR; PG8_MMA(1, 1, At, B1); PG8_BAR;
    }
    { int fr_ = fr, fq_ = fq; asm volatile("" : "+v"(fr_), "+v"(fq_));
      if constexpr (Epi::PRE) E(acc, cur, wr, wc, fr_, fq_, pre); else E(acc, cur, wr, wc, fr_, fq_); }
    if (!has_next) break;
#pragma unroll
    for (int a = 0; a < 2; ++a)
#pragma unroll
      for (int b = 0; b < 2; ++b)
#pragma unroll
        for (int m = 0; m < 4; ++m)
#pragma unroll
          for (int n = 0; n < 2; ++n) acc[a][b][m][n] = (f32x4){0.f, 0.f, 0.f, 0.f};
    cur = nxt; cA = nA; cB = nB; ++ui;
#pragma unroll
    for (int _h = 0; _h < 2; ++_h)
#pragma unroll
      for (int _i = 0; _i < 2; ++_i) vAc[_h][_i] = vAn[_h][_i];
  }
  PG8_WAIT_V(0);
  if (wr == 0) PG8_BAR;
  PG8_BAR;
#undef PG8_SA
#undef PG8_SB
#undef PG8_STAGE
#undef PG8_STAGE_X
#undef PG8_STAGE_A
#undef PG8_AROWS
#undef PG8_LDA
#undef PG8_LDB
#undef PG8_MMA
#undef PG8_WAIT_V
#undef PG8_WAIT_L
#undef PG8_BAR
#undef PG8_SCHED
}
}
using pg8::Unit;

__device__ __forceinline__ unsigned ptok(int tok) { return (unsigned)(tok >> 8) * (27u * 32768u) + (unsigned)((tok & 255) >> 4) * 2048u + (unsigned)(tok & 15) * 8u; }
__device__ __forceinline__ unsigned pcol(int col) { return (unsigned)(col >> 7) * 32768u + (unsigned)((col >> 5) & 3) * 512u + (unsigned)((col >> 3) & 3) * 128u + (unsigned)(col & 7); }
__device__ __forceinline__ unsigned gtok(int tok) { return (unsigned)(tok >> 8) * (16u * 32768u) + (unsigned)((tok & 255) >> 4) * 2048u + (unsigned)(tok & 15) * 8u; }
__device__ __forceinline__ unsigned gcol(int gc) { return (unsigned)(gc >> 7) * 32768u + (unsigned)((gc >> 5) & 3) * 512u + (unsigned)((gc >> 3) & 3) * 128u + (unsigned)(gc & 7); }
struct EpiP {
  static constexpr bool PERM = true; static constexpr bool MID = false; static constexpr bool PRE = false;
  bf16_t* Pm; const float* b_gate; unsigned char* G8;
  __device__ __forceinline__ void operator()(const f32x4 (&acc)[2][2][4][2], const Unit& u, int wr, int wc, int fr, int fq) const {
#pragma unroll
    for (int bj = 0; bj < 2; ++bj) {
      const int col = u.pn * 256 + bj * 128 + wc * 32 + 8 * fq;
      if (col >= INC) continue;
      const unsigned lo = (unsigned)((wr * 16 + wc) * 512 + (fq * 16 + fr) * 8);
      if (col < C_G) {
        bf16_t* tb = Pm + ((size_t)(u.pm * 27 + 2 * u.pn + bj) * 32768 + lo);
#pragma unroll
        for (int ai = 0; ai < 2; ++ai)
#pragma unroll
          for (int m = 0; m < 4; ++m) {
            const f32x4 v0 = acc[ai][bj][m][0], v1 = acc[ai][bj][m][1];
            u32x4 w; w.x = cvt_pk_bf16(v0[0], v0[1]); w.y = cvt_pk_bf16(v0[2], v0[3]); w.z = cvt_pk_bf16(v1[0], v1[1]); w.w = cvt_pk_bf16(v1[2], v1[3]);
            *(u32x4*)(tb + (ai * 32 + m * 4) * 512) = w;
          }
      } else {
        const f32x4 b0 = *(const f32x4*)(b_gate + col - C_G), b1 = *(const f32x4*)(b_gate + col - C_G + 4);
        unsigned char* gb = G8 + ((size_t)(u.pm * 16 + ((col - C_G) >> 7)) * 32768 + lo);
#pragma unroll
        for (int ai = 0; ai < 2; ++ai)
#pragma unroll
          for (int m = 0; m < 4; ++m) {
            const f32x4 v0 = acc[ai][bj][m][0], v1 = acc[ai][bj][m][1];
            unsigned q[8];
#pragma unroll
            for (int j = 0; j < 4; ++j) { q[j] = (unsigned)(sigmoidf_(v0[j] + b0[j]) * 255.f + 0.5f); q[4 + j] = (unsigned)(sigmoidf_(v1[j] + b1[j]) * 255.f + 0.5f); }
            u32x2 w; w.x = q[0] | (q[1] << 8) | (q[2] << 16) | (q[3] << 24); w.y = q[4] | (q[5] << 8) | (q[6] << 16) | (q[7] << 24);
            *(u32x2*)(gb + (ai * 32 + m * 4) * 512) = w;
          }
      }
    }
  }
};
__device__ __forceinline__ void unpack8q(const u32x2 w, float (&f)[8]) {
  f[0] = (float)(w.x & 255u); f[1] = (float)((w.x >> 8) & 255u); f[2] = (float)((w.x >> 16) & 255u); f[3] = (float)(w.x >> 24);
  f[4] = (float)(w.y & 255u); f[5] = (float)((w.y >> 8) & 255u); f[6] = (float)((w.y >> 16) & 255u); f[7] = (float)(w.y >> 24);
}
struct EpiMix {
  static constexpr bool PERM = true; static constexpr bool MID = true; static constexpr bool PRE = false;
  const unsigned char* G8; bf16_t* MIX; GB gw;
  __device__ __forceinline__ void mid(f32x4 (&acc)[2][2][4][2], const Unit& u, int wr, int wc, int fr, int fq) const {
    const int row0 = u.pm * 256 + wr * 64 + fr, col0 = u.pn * 256 + wc * 32 + 8 * fq;
#pragma unroll
    for (int ai = 0; ai < 2; ++ai) {
      u32x2 ga[4][2], gb[4][2];
#pragma unroll
      for (int m = 0; m < 4; ++m)
#pragma unroll
        for (int bj = 0; bj < 2; ++bj) { const unsigned char* gp = G8 + gtok(row0 + ai * 128 + m * 16);
          ga[m][bj] = ld8(gw, gp + gcol(col0 + bj * 128)); gb[m][bj] = ld8(gw, gp + gcol(D + col0 + bj * 128)); }
#pragma unroll
      for (int m = 0; m < 4; ++m)
#pragma unroll
        for (int bj = 0; bj < 2; ++bj) {
          float a[8], b[8]; unpack8q(ga[m][bj], a); unpack8q(gb[m][bj], b);
          f32x4 r0, r1;
#pragma unroll
          for (int j = 0; j < 4; ++j) { r0[j] = a[j] * __builtin_amdgcn_rcpf(fmaxf(b[j], 1e-6f)); r1[j] = a[4 + j] * __builtin_amdgcn_rcpf(fmaxf(b[4 + j], 1e-6f)); }
          acc[ai][bj][m][0] *= r0; acc[ai][bj][m][1] *= r1;
        }
    }
  }
  __device__ __forceinline__ void operator()(const f32x4 (&acc)[2][2][4][2], const Unit& u, int wr, int wc, int fr, int fq) const {
    const int row0 = u.pm * 256 + wr * 64 + fr, col0 = u.pn * 256 + wc * 32 + 8 * fq;
#pragma unroll
    for (int ai = 0; ai < 2; ++ai) {
      u32x2 gb[4][2];
#pragma unroll
      for (int m = 0; m < 4; ++m)
#pragma unroll
        for (int bj = 0; bj < 2; ++bj) gb[m][bj] = ld8(gw, G8 + gtok(row0 + ai * 128 + m * 16) + gcol(D + col0 + bj * 128));
#pragma unroll
      for (int m = 0; m < 4; ++m)
#pragma unroll
        for (int bj = 0; bj < 2; ++bj) {
          float b[8]; unpack8q(gb[m][bj], b);
#pragma unroll
          for (int j = 0; j < 8; ++j) b[j] = fmaxf(b[j], 1e-6f) * (1.f / 255.f);
          const f32x4 v0 = acc[ai][bj][m][0], v1 = acc[ai][bj][m][1];
          u32x4 w; w.x = cvt_pk_bf16(b[0] * v0[0], b[1] * v0[1]); w.y = cvt_pk_bf16(b[2] * v0[2], b[3] * v0[3]); w.z = cvt_pk_bf16(b[4] * v1[0], b[5] * v1[1]); w.w = cvt_pk_bf16(b[6] * v1[2], b[7] * v1[3]);
          *(u32x4*)(MIX + (size_t)(row0 + ai * 128 + m * 16) * D + col0 + bj * 128) = w;
        }
    }
  }
};
struct EpiXout {
  static constexpr bool PERM = true; static constexpr bool MID = false; static constexpr bool PRE = false;
  bf16_t* DL;
  __device__ __forceinline__ void operator()(const f32x4 (&acc)[2][2][4][2], const Unit& u, int wr, int wc, int fr, int fq) const {
    const int row0 = u.pm * 256 + wr * 64 + fr, col0 = u.pn * 256 + wc * 32 + 8 * fq;
#pragma unroll
    for (int ai = 0; ai < 2; ++ai)
#pragma unroll
      for (int m = 0; m < 4; ++m)
#pragma unroll
        for (int bj = 0; bj < 2; ++bj) { const f32x4 v0 = acc[ai][bj][m][0], v1 = acc[ai][bj][m][1];
          u32x4 w; w.x = cvt_pk_bf16(v0[0], v0[1]); w.y = cvt_pk_bf16(v0[2], v0[3]); w.z = cvt_pk_bf16(v1[0], v1[1]); w.w = cvt_pk_bf16(v1[2], v1[3]);
          *(u32x4*)(DL + (size_t)(row0 + ai * 128 + m * 16) * D + col0 + bj * 128) = w; }
  }
};
struct EpiGateUp {
  static constexpr bool PERM = true; static constexpr bool MID = false; static constexpr bool PRE = true;
  bf16_t* HE; const float* LRS; GB gw;
  __device__ __forceinline__ void preload(const Unit& u, int wr, int fr, float (&pre)[8]) const {
#pragma unroll
    for (int ai = 0; ai < 2; ++ai)
#pragma unroll
      for (int m = 0; m < 4; ++m) pre[ai * 4 + m] = ld4f(gw, LRS + (size_t)u.l * NTOK + u.r0 + wr * 64 + fr + ai * 128 + m * 16);
  }
  __device__ __forceinline__ void operator()(const f32x4 (&acc)[2][2][4][2], const Unit& u, int wr, int wc, int fr, int fq, const float (&pre)[8]) const {
    const int row0 = u.pm * 256 + wr * 64 + fr, col = (u.pn & 1) * 128 + wc * 32 + 8 * fq;
#pragma unroll
    for (int ai = 0; ai < 2; ++ai)
#pragma unroll
      for (int m = 0; m < 4; ++m) {
        const int row = row0 + ai * 128 + m * 16; const float rs = pre[ai * 4 + m];
        const f32x4 g0 = acc[ai][0][m][0] * rs, g1 = acc[ai][0][m][1] * rs, u0 = acc[ai][1][m][0] * rs, u1 = acc[ai][1][m][1] * rs;
        f32x4 o0, o1;
#pragma unroll
        for (int j = 0; j < 4; ++j) { o0[j] = g0[j] * sigmoidf_(g0[j]) * u0[j]; o1[j] = g1[j] * sigmoidf_(g1[j]) * u1[j]; }
        u32x4 w; w.x = cvt_pk_bf16(o0[0], o0[1]); w.y = cvt_pk_bf16(o0[2], o0[3]); w.z = cvt_pk_bf16(o1[0], o1[1]); w.w = cvt_pk_bf16(o1[2], o1[3]);
        *(u32x4*)(HE + (size_t)row * 256 + col) = w;
      }
  }
};
struct EpiDown {
  static constexpr bool PERM = true; static constexpr bool MID = false; static constexpr bool PRE = true;
  const float* LW; bf16_t* O; GB gw;
  __device__ __forceinline__ void preload(const Unit& u, int wr, int fr, float (&pre)[8]) const {
#pragma unroll
    for (int ai = 0; ai < 2; ++ai)
#pragma unroll
      for (int m = 0; m < 4; ++m) pre[ai * 4 + m] = ld4f(gw, LW + (size_t)u.l * NTOK + u.r0 + wr * 64 + fr + ai * 128 + m * 16);
  }
  __device__ __forceinline__ void operator()(const f32x4 (&acc)[2][2][4][2], const Unit& u, int wr, int wc, int fr, int fq, const float (&pre)[8]) const {
    const int row0 = u.pm * 256 + wr * 64 + fr, colb = (u.pn & 3) * 256 + wc * 32 + 8 * fq;
#pragma unroll
    for (int ai = 0; ai < 2; ++ai)
#pragma unroll
      for (int m = 0; m < 4; ++m) {
        bf16_t* op = O + (size_t)(row0 + ai * 128 + m * 16) * D + colb; const float ww = pre[ai * 4 + m];
#pragma unroll
        for (int bj = 0; bj < 2; ++bj) { const f32x4 v0 = acc[ai][bj][m][0] * ww, v1 = acc[ai][bj][m][1] * ww;
          u32x4 pk; pk.x = cvt_pk_bf16(v0[0], v0[1]); pk.y = cvt_pk_bf16(v0[2], v0[3]); pk.z = cvt_pk_bf16(v1[0], v1[1]); pk.w = cvt_pk_bf16(v1[2], v1[3]);
          *(u32x4*)(op + bj * 128) = pk; }
      }
  }
};

struct TDesc { const float* W; bf16_t* Wt; int ldw, k0, n0, K, drow0; };
template <class DescOf>
__device__ __forceinline__ void transpose_items(int first, int count, int stride, const DescOf& desc_of, float* sm) {
  int tid_ = threadIdx.x; asm volatile("" : "+v"(tid_)); const int tid = tid_;
  float r[8], rn[8]; TDesc d{}, dn{};
#define TT_LOAD(DD, RR) do { _Pragma("unroll") for (int i_ = 0; i_ < 8; ++i_) { const int e_ = tid + i_ * NTHR; RR[i_] = __builtin_nontemporal_load(DD.W + (size_t)(DD.k0 + (e_ >> 6)) * DD.ldw + DD.n0 + (e_ & 63)); } } while (0)
  int it = first;
  if (it < count) { d = desc_of(it); TT_LOAD(d, r); }
  for (; it < count; it += stride) {
    const int nx = it + stride;
    __syncthreads();
#pragma unroll
    for (int i = 0; i < 8; ++i) { const int e = tid + i * NTHR; sm[(e >> 6) * 65 + (e & 63)] = r[i]; }
    if (nx < count) { dn = desc_of(nx); TT_LOAD(dn, rn); }
    __syncthreads();
    { const int n = tid >> 3, kc = tid & 7;
      float f[8];
#pragma unroll
      for (int q = 0; q < 8; ++q) f[q] = sm[(kc * 8 + q) * 65 + n];
      u32x4 w; w.x = cvt_pk_bf16(f[0], f[1]); w.y = cvt_pk_bf16(f[2], f[3]); w.z = cvt_pk_bf16(f[4], f[5]); w.w = cvt_pk_bf16(f[6], f[7]);
      *(u32x4*)(d.Wt + (size_t)(d.drow0 + n) * d.K + d.k0 + kc * 8) = w; }
    d = dn;
#pragma unroll
    for (int i = 0; i < 8; ++i) r[i] = rn[i];
  }
#undef TT_LOAD
}
struct ProDesc {
  const float *w_in, *w_oa, *w_ob, *w_out, *g_up; unsigned char* ws;
  static constexpr int I1 = 16 * 86, I2 = 8 * 16, I3 = 8 * 16, I4 = 16 * 16, I5 = 2 * 8, COUNT = I1 + I2 + I3 + I4 + I5;
  __device__ __forceinline__ TDesc operator()(int it) const {
    int r = it;
    if (r < I1) return TDesc{w_in, (bf16_t*)(ws + WS_W1T), INC, (r / 86) * 64, (r % 86) * 64, D, (r % 86) * 64}; r -= I1;
    if (r < I2) return TDesc{w_oa, (bf16_t*)(ws + WS_WOA), D, (r / 16) * 64, (r % 16) * 64, D, (r % 16) * 64}; r -= I2;
    if (r < I3) return TDesc{w_ob, (bf16_t*)(ws + WS_WOA) + 512, D, (r / 16) * 64, (r % 16) * 64, D, (r % 16) * 64}; r -= I3;
    if (r < I4) return TDesc{w_out, (bf16_t*)(ws + WS_WOUT), D, (r / 16) * 64, (r % 16) * 64, D, (r % 16) * 64}; r -= I4;
    return TDesc{g_up, (bf16_t*)(ws + WS_GUPT), 512, (r / 8) * 64, (r % 8) * 64, 128, (r % 8) * 64};
  }
};
constexpr int XT_PER_WG = 24;
struct ExpDesc {
  const float *wg, *wu, *wd; unsigned char* ws;
  static constexpr int COUNT = 3 * 2048;
  __device__ __forceinline__ TDesc operator()(int it) const {
    const int mat = it >> 11, r = it & 2047, e = r >> 6, q = r & 63;
    if (mat < 2) { const int kt = q >> 2, j0 = (q & 3) * 64;
      return TDesc{(mat ? wu : wg) + (size_t)e * D * 256, (bf16_t*)(ws + WS_WGU) + (size_t)e * 512 * D, 256, kt * 64, j0, D, (j0 >> 7) * 256 + mat * 128 + (j0 & 127)}; }
    const int kt = q >> 4, ntl = q & 15;
    return TDesc{wd + (size_t)e * 256 * D, (bf16_t*)(ws + WS_WD) + (size_t)e * D * 256, D, kt * 64, ntl * 64, 256, ntl * 64};
  }
};

__device__ void phase_prologue(const Params& P, float* sm) {
  bf16_t* W1T = (bf16_t*)(P.ws + WS_W1T); bf16_t* WOA = (bf16_t*)(P.ws + WS_WOA); bf16_t* WOB = (bf16_t*)(P.ws + WS_WOB); bf16_t* WOUT = (bf16_t*)(P.ws + WS_WOUT);
  { const ProDesc pd{P.in[2], P.in[23], P.in[24], P.in[25], P.in[13], P.ws}; transpose_items((int)blockIdx.x, ProDesc::COUNT, (int)gridDim.x, pd, sm); }
  {
    u32x4* z = (u32x4*)(W1T + (size_t)INC * D);
    for (int i = blockIdx.x * NTHR + threadIdx.x; i < 16384; i += gridDim.x * NTHR) z[i] = (u32x4){0u, 0u, 0u, 0u};
  }
  if (blockIdx.x == 0 && threadIdx.x < 64) ((int*)(P.ws + WS_CNT))[threadIdx.x] = 0;
  { float* WR = (float*)(P.ws + WS_WR); const float* w_rg = P.in[27]; const float* w_re = P.in[29];
    for (int e = blockIdx.x * NTHR + threadIdx.x; e < D * 48; e += gridDim.x * NTHR) { const int k = e / 48, o = e - k * 48; WR[e] = o < 32 ? w_re[k * 32 + o] : (o < 36 ? w_rg[k * 4 + o - 32] : 0.f); } }

  const float* x = P.in[0]; const float* g = P.in[1]; bf16_t* H = (bf16_t*)(P.ws + WS_H);
  const int lane = threadIdx.x & 63, gw = blockIdx.x * 8 + (threadIdx.x >> 6), ngw = gridDim.x * 8;
  f32x4 gv[4];
#pragma unroll
  for (int j = 0; j < 4; ++j) gv[j] = *(const f32x4*)(g + (lane + 64 * j) * 4);
  f32x4 vc[4], vn[4];
#define NRM_LOAD(V, M) do { _Pragma("unroll") for (int j_ = 0; j_ < 4; ++j_) V[j_] = __builtin_nontemporal_load((const f32x4*)(x + (size_t)(M) * D) + lane + 64 * j_); } while (0)
  if (gw < NTOK) NRM_LOAD(vc, gw);
  for (int m = gw; m < NTOK; m += ngw) {
    if (m + ngw < NTOK) NRM_LOAD(vn, m + ngw);
    float ss = 0.f;
#pragma unroll
    for (int j = 0; j < 4; ++j) ss += vc[j][0] * vc[j][0] + vc[j][1] * vc[j][1] + vc[j][2] * vc[j][2] + vc[j][3] * vc[j][3];
    ss = wave_sum(ss);
    const float rs = __builtin_amdgcn_rsqf(ss * (1.f / D) + 1e-6f);
#pragma unroll
    for (int j = 0; j < 4; ++j) {
      const f32x4 t = vc[j] * rs * gv[j];
      u32x2 o; o.x = cvt_pk_bf16(t[0], t[1]); o.y = cvt_pk_bf16(t[2], t[3]);
      *(u32x2*)(H + (size_t)m * D + (lane + 64 * j) * 4) = o;
    }
#pragma unroll
    for (int j = 0; j < 4; ++j) vc[j] = vn[j];
  }
#undef NRM_LOAD
}

__device__ __forceinline__ float fast_tanh(float x) { return 1.f - 2.f * __builtin_amdgcn_rcpf(__expf(2.f * x) + 1.f); }
__device__ void phase_scan(const Params& P, LAS unsigned char* lds) {
  const GB gws = GB_WS(P);
  constexpr int L_UPW = 0, L_UPA = 8192, L_INW = 16384, L_INA = 24576, L_RKV = 32768,
                L_AABT = 32768, L_AAKT = 36864, L_ABRT = 38912, L_AKRT = 40960, L_TT = 43008,
                L_XT = 45056,
                L_INVN = 81920, L_BON = 82176, L_MU = 83200, L_GAM = 85760,
                L_AT = 87040, L_BT = 95232, L_KT = 103424, L_RT = 111616, L_VT = 136192, L_RAW = 87040;
  const bf16_t* Pm = (const bf16_t*)(P.ws + WS_P);
  float* yd = P.out;
  float* sd = (float*)(P.ws + WS_SD);
  bf16_t* vblk = (bf16_t*)(P.ws + WS_VBLK);
  int tid_ = threadIdx.x; asm volatile("" : "+v"(tid_));
  const int tid = tid_, wid = __builtin_amdgcn_readfirstlane(tid >> 6), lane = tid & 63, fr = lane & 15, fq = lane >> 4;
  const int tok_s = tid >> 3, cch = tid & 7;
  const int nt = wid & 3, mth = wid >> 2;
  const int cE = 16 * nt + fr;
  LAS float* invn = (LAS float*)(lds + L_INVN); LAS float* bon = (LAS float*)(lds + L_BON); LAS float* mus = (LAS float*)(lds + L_MU); LAS float* gam = (LAS float*)(lds + L_GAM);
  for (int chain = blockIdx.x; chain < 256; chain += gridDim.x) {
    const int dir = chain >> 7, b = (chain >> 3) & 15, h = chain & 7;
    const float* w0 = P.in[dir ? 7 : 5]; const float* wu = P.in[dir ? 8 : 6]; const float* a0 = P.in[dir ? 11 : 9]; const float* au = P.in[dir ? 12 : 10];
    __syncthreads();
#pragma unroll
    for (int i = 0; i < 8; ++i) { const int e = tid + i * NTHR, j = e >> 6, c = e & 63;
      const int off = c * 128 + (((j >> 3) ^ (c & 7)) << 4) + (j & 7) * 2;
      *(LAS bf16_t*)(lds + L_UPW + off) = f2bf(wu[j * 512 + h * 64 + c]); *(LAS bf16_t*)(lds + L_UPA + off) = f2bf(au[j * 512 + h * 64 + c]); }
    for (int e = tid; e < 640; e += NTHR) { const int which = e / 320, r = e % 320, seg = r >> 6, c = r & 63;
      const int col = (seg == 0 ? C_R + h * 64 : seg == 1 ? C_K + h * 64 : seg == 2 ? C_V + h * 64 : seg == 3 ? C_WL + dir * 64 : C_AL + dir * 64) + c;
      mus[e] = P.in[3 + which][col]; }
    float kks[8];
#pragma unroll
    for (int j = 0; j < 8; ++j) kks[j] = P.in[14][h * 64 + cch * 8 + j];
    const float w0c = w0[h * 64 + cE], a0c = a0[h * 64 + cE], kkc = P.in[14][h * 64 + cE], kac = P.in[15][h * 64 + cE], rkc = P.in[16][h * 64 + cE];
    f32x4 S[4];
#pragma unroll
    for (int j = 0; j < 4; ++j) S[j] = (f32x4){0.f, 0.f, 0.f, 0.f};
    u32x4 pc[5], ph = (u32x4){0u, 0u, 0u, 0u};
#define SCAN_LOAD(NB) do { const int sidx_ = (NB) * 64 + tok_s; const int tt_ = dir ? (T - 1 - sidx_) : sidx_; \
      const bf16_t* rowp_ = Pm + ptok(b * T + tt_); \
      _Pragma("unroll") for (int seg = 0; seg < 5; ++seg) { \
        const int col_ = (seg == 0 ? C_R + h * 64 : seg == 1 ? C_K + h * 64 : seg == 2 ? C_V + h * 64 : seg == 3 ? C_WL + dir * 64 : C_AL + dir * 64) + cch * 8; \
        pc[seg] = ld16(gws, rowp_ + pcol(col_)); } \
      if (tid < 80) { const int hs_ = (NB) * 64 + (tid >= 40 ? 64 : -1); const int th_ = dir ? (T - 1 - hs_) : hs_; const int sg_ = (tid % 40) >> 3; \
        const int colh_ = (sg_ == 0 ? C_R + h * 64 : sg_ == 1 ? C_K + h * 64 : sg_ == 2 ? C_V + h * 64 : sg_ == 3 ? C_WL + dir * 64 : C_AL + dir * 64) + (tid & 7) * 8; \
        ph = (u32x4){0u, 0u, 0u, 0u}; if (th_ >= 0 && th_ < T) ph = ld16(gws, Pm + ptok(b * T + th_) + pcol(colh_)); } } while (0)
    SCAN_LOAD(0);
    const ExpDesc xed{P.in[31], P.in[32], P.in[33], P.ws};
    const bool xdo = (chain == (int)blockIdx.x) && wid >= 4;
#define XT_LOAD(J) do { const int it_ = (int)blockIdx.x + (J) * (int)gridDim.x; if (xdo && (J) < XT_PER_WG && it_ < ExpDesc::COUNT) { const TDesc d_ = xed(it_); \
        const float* sp_ = d_.W + (size_t)(d_.k0 + (lane >> 2)) * d_.ldw + d_.n0 + 16 * (wid - 4) + 4 * (lane & 3); \
        _Pragma("unroll") for (int j_ = 0; j_ < 4; ++j_) S[j_] = __builtin_nontemporal_load((const f32x4*)(sp_ + (size_t)(16 * j_) * d_.ldw)); } } while (0)
    XT_LOAD(0);
    for (int nb = 0; nb < 32; ++nb) {
      __syncthreads();
      {
#pragma unroll
        for (int seg = 0; seg < 5; ++seg) *(LAS u32x4*)(lds + L_RAW + ((tok_s + 1) * 5 + seg) * 128 + cch * 16) = pc[seg];
        if (tid < 80) *(LAS u32x4*)(lds + L_RAW + ((tid >= 40 ? 65 : 0) * 5) * 128 + (tid % 40) * 16) = ph;
      }
      if (nb + 1 < 32) SCAN_LOAD(nb + 1);
      __syncthreads();
      {
        const int rp = dir ? tok_s + 2 : tok_s, rn = dir ? tok_s : tok_s + 2;
#pragma unroll
        for (int seg = 0; seg < 5; ++seg) {
          const u32x4 c4 = *(const LAS u32x4*)(lds + L_RAW + ((tok_s + 1) * 5 + seg) * 128 + cch * 16);
          const u32x4 p4 = *(const LAS u32x4*)(lds + L_RAW + (rp * 5 + seg) * 128 + cch * 16), n4 = *(const LAS u32x4*)(lds + L_RAW + (rn * 5 + seg) * 128 + cch * 16);
          float cf[8], pf[8], nf[8], val[8]; unpack8f(c4, cf); unpack8f(p4, pf); unpack8f(n4, nf);
          const f32x4 mp0 = *(const LAS f32x4*)(mus + seg * 64 + cch * 8), mp1 = *(const LAS f32x4*)(mus + seg * 64 + cch * 8 + 4);
          const f32x4 mn0 = *(const LAS f32x4*)(mus + 320 + seg * 64 + cch * 8), mn1 = *(const LAS f32x4*)(mus + 320 + seg * 64 + cch * 8 + 4);
#pragma unroll
          for (int j = 0; j < 8; ++j) { const float mp = j < 4 ? mp0[j & 3] : mp1[j & 3], mn = j < 4 ? mn0[j & 3] : mn1[j & 3]; val[j] = cf[j] + mp * (pf[j] - cf[j]) + mn * (nf[j] - cf[j]); }
          if (seg < 3) {
            LAS float* dst = (LAS float*)(lds + L_RKV + seg * 16384) + tok_s * 64 + cch * 8;
            *(LAS f32x4*)dst = (f32x4){val[0], val[1], val[2], val[3]}; *(LAS f32x4*)(dst + 4) = (f32x4){val[4], val[5], val[6], val[7]};
            if (seg == 1) { float ss = 0.f;
#pragma unroll
              for (int j = 0; j < 8; ++j) { const float q = val[j] * kks[j]; ss += q * q; }
              ss = sum8(ss);
              if (cch == 0) invn[tok_s] = __builtin_amdgcn_rsqf(ss + 1e-12f); }
          } else {
            if (seg == 3) {
#pragma unroll
              for (int j = 0; j < 8; ++j) val[j] = fast_tanh(val[j]); }
            u32x4 w; w.x = cvt_pk_bf16(val[0], val[1]); w.y = cvt_pk_bf16(val[2], val[3]); w.z = cvt_pk_bf16(val[4], val[5]); w.w = cvt_pk_bf16(val[6], val[7]);
            *(LAS u32x4*)(lds + (seg == 3 ? L_INW : L_INA) + tok_s * 128 + ((cch ^ (tok_s & 7)) << 4)) = w;
          }
        } }
      __syncthreads();
      { bf16x8 bw[2], ba[2];
#pragma unroll
        for (int ks = 0; ks < 2; ++ks) { const int o = cE * 128 + (((ks * 4 + fq) ^ (cE & 7)) << 4); bw[ks] = *(const LAS bf16x8*)(lds + L_UPW + o); ba[ks] = *(const LAS bf16x8*)(lds + L_UPA + o); }
#pragma unroll 1
        for (int mi = 0; mi < 2; ++mi) {
          const int mt = 2 * mth + mi, tok0 = 16 * mt + 4 * fq;
          f32x4 accWm = (f32x4){0.f, 0.f, 0.f, 0.f}, accAm = accWm;
          { const int trow = 16 * mt + fr;
#pragma unroll
            for (int ks = 0; ks < 2; ++ks) { const int o = trow * 128 + (((ks * 4 + fq) ^ (trow & 7)) << 4);
              accWm = __builtin_amdgcn_mfma_f32_16x16x32_bf16(*(const LAS bf16x8*)(lds + L_INW + o), bw[ks], accWm, 0, 0, 0);
              accAm = __builtin_amdgcn_mfma_f32_16x16x32_bf16(*(const LAS bf16x8*)(lds + L_INA + o), ba[ks], accAm, 0, 0, 0); } }
          float lw[4], kd[4], al_[4], be[4], rr[4], vv[4], bx4[4];
          unsigned rkvb = (unsigned)(size_t)(lds + L_RKV) + (unsigned)((tok0 * 64 + cE) * 4); asm volatile("" : "+v"(rkvb));
          const f32x4 inv4 = *(const LAS f32x4*)(invn + tok0);
#pragma unroll
          for (int rg = 0; rg < 4; ++rg) { const int tok = tok0 + rg;
            lw[rg] = -0.6065306597126334f * sigmoidf_(accWm[rg] + w0c);
            const float a = sigmoidf_(accAm[rg] + a0c);
            const float r = *(const LAS float*)(size_t)(rkvb + rg * 256), k = *(const LAS float*)(size_t)(rkvb + rg * 256 + 16384), v = *(const LAS float*)(size_t)(rkvb + rg * 256 + 32768);
            const float kkv = k * kkc * inv4[rg];
            kd[rg] = k * (1.f + (a - 1.f) * kac); al_[rg] = -kkv; be[rg] = kkv * a; rr[rg] = r; vv[rg] = v;
            bx4[rg] = r * kd[rg] * rkc; }
          { const float bs = sum16x4(bx4, fr); if (fr < 4) bon[nt * 64 + tok0 + fr] = bs; }
          float Lc[4]; Lc[0] = lw[0]; Lc[1] = Lc[0] + lw[1]; Lc[2] = Lc[1] + lw[2]; Lc[3] = Lc[2] + lw[3];
          { const float g = Lc[3]; const float t1 = __shfl_up(g, 16), t2 = __shfl_up(g, 32), t3 = __shfl_up(g, 48);
            const float e = (fq >= 1 ? t1 : 0.f) + (fq >= 2 ? t2 : 0.f) + (fq >= 3 ? t3 : 0.f);
#pragma unroll
            for (int rg = 0; rg < 4; ++rg) Lc[rg] += e; }
          const float L16 = __shfl(Lc[3], 48 + fr);
          { float va[4], vb[4], vk[4], vr2[4];
            float eLprev = __expf(Lc[0] - lw[0]);
#pragma unroll
            for (int rg = 0; rg < 4; ++rg) { const float eL = __expf(Lc[rg]), enL = __builtin_amdgcn_rcpf(eL);
              va[rg] = al_[rg] * eLprev; vb[rg] = be[rg] * enL; vk[rg] = kd[rg] * enL; vr2[rg] = rr[rg] * eL; eLprev = eL; }
#pragma unroll
            for (int pr = 0; pr < 2; ++pr) { const int tk0 = tok0 + 2 * pr, tk1 = tk0 + 1;
              const int off0 = tk0 * 128 + (((cE >> 3) ^ (tk0 & 7)) << 4) + (cE & 7) * 2, off1 = tk1 * 128 + (((cE >> 3) ^ (tk1 & 7)) << 4) + (cE & 7) * 2;
              unsigned q0 = (unsigned)(size_t)(lds + L_AT) + (unsigned)off0, q1 = (unsigned)(size_t)(lds + L_AT) + (unsigned)off1; asm volatile("" : "+v"(q0), "+v"(q1));
#define IMG(q, L) (*(LAS bf16_t*)(size_t)((q) + ((L) - L_AT)))
              const unsigned pa = cvt_pk_bf16(va[2 * pr], va[2 * pr + 1]), pb = cvt_pk_bf16(vb[2 * pr], vb[2 * pr + 1]), pk = cvt_pk_bf16(vk[2 * pr], vk[2 * pr + 1]),
                             pq = cvt_pk_bf16(vr2[2 * pr], vr2[2 * pr + 1]), pv = cvt_pk_bf16(vv[2 * pr], vv[2 * pr + 1]);
              IMG(q0, L_AT) = (bf16_t)pa; IMG(q1, L_AT) = (bf16_t)(pa >> 16);
              IMG(q0, L_BT) = (bf16_t)pb; IMG(q1, L_BT) = (bf16_t)(pb >> 16);
              IMG(q0, L_KT) = (bf16_t)pk; IMG(q1, L_KT) = (bf16_t)(pk >> 16);
              IMG(q0, L_RT) = (bf16_t)pq; IMG(q1, L_RT) = (bf16_t)(pq >> 16);
              IMG(q0, L_VT) = (bf16_t)pv; IMG(q1, L_VT) = (bf16_t)(pv >> 16);
#undef IMG
            } }
          if (fq == 0) gam[mt * 64 + cE] = __expf(L16);
          if (dir == 0) { u32x2 w; w.x = cvt_pk_bf16(vv[0], vv[1]); w.y = cvt_pk_bf16(vv[2], vv[3]);
            *(u32x2*)(vblk + ((((size_t)b * 8 + h) * 128 + nb * 4 + mt) * 4 + nt) * 256 + lane * 4) = w; }
        } }
      __syncthreads();
      { const int sc = wid >> 1, pp = wid & 1, rowA = 16 * sc + fr, sw = rowA & 7;
        const f32x4 z = (f32x4){0.f, 0.f, 0.f, 0.f};
#define OPND(a) __builtin_bit_cast(bf16x8, ((u32x4){cvt_pk_bf16((a)[0], (a)[1]), cvt_pk_bf16((a)[2], (a)[3]), 0u, 0u}))
        if (pp == 0) {
          f32x4 nt = z, nm = z, d2 = z;
#pragma unroll
          for (int ks = 0; ks < 2; ++ks) { const int o = rowA * 128 + (((ks * 4 + fq) ^ sw) << 4);
            const bf16x8 fa = *(const LAS bf16x8*)(lds + L_AT + o), fb = *(const LAS bf16x8*)(lds + L_BT + o), fk = *(const LAS bf16x8*)(lds + L_KT + o);
            nt = __builtin_amdgcn_mfma_f32_16x16x32_bf16(fb, fa, nt, 0, 0, 0);
            nm = __builtin_amdgcn_mfma_f32_16x16x32_bf16(fa, fb, nm, 0, 0, 0);
            d2 = __builtin_amdgcn_mfma_f32_16x16x32_bf16(fk, fa, d2, 0, 0, 0); }
#pragma unroll
          for (int rg = 0; rg < 4; ++rg) { const int rr = 4 * fq + rg;
            nt[rg] = rr < fr ? nt[rg] : 0.f; d2[rg] = rr < fr ? d2[rg] : 0.f;
            nm[rg] = rr > fr ? nm[rg] : 0.f; }
          { u32x2 w2; w2.x = cvt_pk_bf16(d2[0], d2[1]); w2.y = cvt_pk_bf16(d2[2], d2[3]); *(LAS u32x2*)(lds + L_AAKT + sc * 512 + fr * 32 + fq * 8) = w2; }
          f32x4 X = nm, Xt = nt, Pm_ = nm, Pt_ = nt;
#pragma unroll
          for (int rg = 0; rg < 4; ++rg) { const float one = (4 * fq + rg == fr) ? 1.f : 0.f; X[rg] += one; Xt[rg] += one; }
#pragma unroll
          for (int it = 0; it < 3; ++it) {
            const bf16x8 oP = OPND(Pm_), oPt = OPND(Pt_);
            const f32x4 P2 = __builtin_amdgcn_mfma_f32_16x16x32_bf16(oPt, oP, z, 0, 0, 0);
            const f32x4 P2t = __builtin_amdgcn_mfma_f32_16x16x32_bf16(oP, oPt, z, 0, 0, 0);
            const bf16x8 oX = OPND(X), oXt = OPND(Xt), oP2 = OPND(P2), oP2t = OPND(P2t);
            const f32x4 Xn = __builtin_amdgcn_mfma_f32_16x16x32_bf16(oXt, oP2, X, 0, 0, 0);
            const f32x4 Xtn = __builtin_amdgcn_mfma_f32_16x16x32_bf16(oP2, oXt, Xt, 0, 0, 0);
            (void)oX; (void)oP2t;
            X = Xn; Xt = Xtn; Pm_ = P2; Pt_ = P2t;
          }
          { u32x2 w; w.x = cvt_pk_bf16(Xt[0], Xt[1]); w.y = cvt_pk_bf16(Xt[2], Xt[3]); *(LAS u32x2*)(lds + L_TT + sc * 512 + fr * 32 + fq * 8) = w; }
        } else {
          f32x4 d1 = z, d2 = z;
#pragma unroll
          for (int ks = 0; ks < 2; ++ks) { const int o = rowA * 128 + (((ks * 4 + fq) ^ sw) << 4);
            const bf16x8 yb = *(const LAS bf16x8*)(lds + L_RT + o);
            d1 = __builtin_amdgcn_mfma_f32_16x16x32_bf16(*(const LAS bf16x8*)(lds + L_BT + o), yb, d1, 0, 0, 0);
            d2 = __builtin_amdgcn_mfma_f32_16x16x32_bf16(*(const LAS bf16x8*)(lds + L_KT + o), yb, d2, 0, 0, 0); }
#pragma unroll
          for (int rg = 0; rg < 4; ++rg) { const bool keep = (4 * fq + rg) <= fr; d1[rg] = keep ? d1[rg] : 0.f; d2[rg] = keep ? d2[rg] : 0.f; }
          u32x2 w1, w2; w1.x = cvt_pk_bf16(d1[0], d1[1]); w1.y = cvt_pk_bf16(d1[2], d1[3]); w2.x = cvt_pk_bf16(d2[0], d2[1]); w2.y = cvt_pk_bf16(d2[2], d2[3]);
          *(LAS u32x2*)(lds + L_ABRT + sc * 512 + fr * 32 + fq * 8) = w1; *(LAS u32x2*)(lds + L_AKRT + sc * 512 + fr * 32 + fq * 8) = w2;
          if (wid == 1) { const int sidx = nb * 64 + lane; const int tt = dir ? (T - 1 - sidx) : sidx;
            sd[((size_t)dir * 128 + b * 8 + h) * T + tt] = (bon[lane] + bon[64 + lane]) + (bon[128 + lane] + bon[192 + lane]); }
        }
#undef OPND
      }
      __syncthreads();
      if (wid >= 4) {
        const int it = (int)blockIdx.x + nb * (int)gridDim.x;
        if (xdo && nb < XT_PER_WG && it < ExpDesc::COUNT) {
          const TDesc d = xed(it);
          LAS unsigned char* xp = lds + L_XT + (wid - 4) * 2048;
#pragma unroll
          for (int j = 0; j < 4; ++j) { const unsigned p0 = cvt_pk_bf16(S[j][0], S[j][1]), p1 = cvt_pk_bf16(S[j][2], S[j][3]);
            LAS unsigned char* q = xp + (4 * (lane & 3)) * 128 + (16 * j + (lane >> 2)) * 2;
            *(LAS bf16_t*)(q) = (bf16_t)p0; *(LAS bf16_t*)(q + 128) = (bf16_t)(p0 >> 16);
            *(LAS bf16_t*)(q + 256) = (bf16_t)p1; *(LAS bf16_t*)(q + 384) = (bf16_t)(p1 >> 16); }
          asm volatile("s_waitcnt lgkmcnt(0)" ::: "memory");
#pragma unroll
          for (int i = 0; i < 2; ++i) { const int c = lane + 64 * i, nl = c >> 3, kc = c & 7;
            const u32x4 w = *(const LAS u32x4*)(xp + nl * 128 + kc * 16);
            *(u32x4*)(d.Wt + (size_t)(d.drow0 + 16 * (wid - 4) + nl) * d.K + d.k0 + kc * 8) = w; }
          asm volatile("" ::: "memory");
        }
        XT_LOAD(nb + 1);
      }
      if (wid < 4) {
#pragma unroll 2
        for (int sc = 0; sc < 4; ++sc) {
          const int rowt = 16 * sc + fr, swt = rowt & 7;
          u32x4 sb0, sb1;
          sb0.x = cvt_pk_bf16(S[0][0], S[0][1]); sb0.y = cvt_pk_bf16(S[0][2], S[0][3]); sb0.z = cvt_pk_bf16(S[1][0], S[1][1]); sb0.w = cvt_pk_bf16(S[1][2], S[1][3]);
          sb1.x = cvt_pk_bf16(S[2][0], S[2][1]); sb1.y = cvt_pk_bf16(S[2][2], S[2][3]); sb1.z = cvt_pk_bf16(S[3][0], S[3][1]); sb1.w = cvt_pk_bf16(S[3][2], S[3][3]);
          const bf16x8 Sb0 = __builtin_bit_cast(bf16x8, sb0), Sb1 = __builtin_bit_cast(bf16x8, sb1);
          const int rowv = 16 * sc + 4 * fq + (fr >> 2), pq = fr & 3;
          s16x4 vf, bhf[4], khf[4];
          { const int va = L_VT + rowv * 128 + (((2 * wid + (pq >> 1)) ^ (rowv & 7)) << 4) + (pq & 1) * 8;
            vf = lds_tr16(lds, va); }
#pragma unroll
          for (int jt = 0; jt < 4; ++jt) { const int o = rowv * 128 + (((2 * jt + (pq >> 1)) ^ (rowv & 7)) << 4) + (pq & 1) * 8;
            bhf[jt] = lds_tr16(lds, L_BT + o); khf[jt] = lds_tr16(lds, L_KT + o); }
          u32x2 alo[2], ahi[2], rlo[2], rhi[2];
#pragma unroll
          for (int ks = 0; ks < 2; ++ks) { const int c1 = 4 * ks + (fq >> 1), sub = 8 * (fq & 1);
            const int o1 = rowt * 128 + ((c1 ^ swt) << 4) + sub, o2 = rowt * 128 + (((c1 + 2) ^ swt) << 4) + sub;
            alo[ks] = *(const LAS u32x2*)(lds + L_AT + o1); ahi[ks] = *(const LAS u32x2*)(lds + L_AT + o2);
            rlo[ks] = *(const LAS u32x2*)(lds + L_RT + o1); rhi[ks] = *(const LAS u32x2*)(lds + L_RT + o2); }
          const u32x2 aak = *(const LAS u32x2*)(lds + L_AAKT + sc * 512 + fr * 32 + fq * 8), ttf = *(const LAS u32x2*)(lds + L_TT + sc * 512 + fr * 32 + fq * 8);
          const u32x2 abr = *(const LAS u32x2*)(lds + L_ABRT + sc * 512 + fr * 32 + fq * 8), akr = *(const LAS u32x2*)(lds + L_AKRT + sc * 512 + fr * 32 + fq * 8);
          f32x4 gm[4];
#pragma unroll
          for (int jt = 0; jt < 4; ++jt) gm[jt] = *(const LAS f32x4*)(gam + sc * 64 + 16 * jt + 4 * fq);
          const u32x2 vfu = __builtin_bit_cast(u32x2, vf);
          const f32x4 z = (f32x4){0.f, 0.f, 0.f, 0.f};
          f32x4 Up = __builtin_amdgcn_mfma_f32_16x16x32_bf16(__builtin_bit_cast(bf16x8, ((u32x4){alo[0].x, alo[0].y, ahi[0].x, ahi[0].y})), Sb0, z, 0, 0, 0);
          Up = __builtin_amdgcn_mfma_f32_16x16x32_bf16(__builtin_bit_cast(bf16x8, ((u32x4){alo[1].x, alo[1].y, ahi[1].x, ahi[1].y})), Sb1, Up, 0, 0, 0);
          Up = __builtin_amdgcn_mfma_f32_16x16x32_bf16(__builtin_bit_cast(bf16x8, ((u32x4){aak.x, aak.y, 0u, 0u})), __builtin_bit_cast(bf16x8, ((u32x4){vfu.x, vfu.y, 0u, 0u})), Up, 0, 0, 0);
          const f32x4 U = __builtin_amdgcn_mfma_f32_16x16x32_bf16(__builtin_bit_cast(bf16x8, ((u32x4){ttf.x, ttf.y, 0u, 0u})),
                                                                  __builtin_bit_cast(bf16x8, ((u32x4){cvt_pk_bf16(Up[0], Up[1]), cvt_pk_bf16(Up[2], Up[3]), 0u, 0u})), z, 0, 0, 0);
          const bf16x8 UB = __builtin_bit_cast(bf16x8, ((u32x4){cvt_pk_bf16(U[0], U[1]), cvt_pk_bf16(U[2], U[3]), vfu.x, vfu.y}));
          f32x4 Y = __builtin_amdgcn_mfma_f32_16x16x32_bf16(__builtin_bit_cast(bf16x8, ((u32x4){rlo[0].x, rlo[0].y, rhi[0].x, rhi[0].y})), Sb0, z, 0, 0, 0);
          Y = __builtin_amdgcn_mfma_f32_16x16x32_bf16(__builtin_bit_cast(bf16x8, ((u32x4){rlo[1].x, rlo[1].y, rhi[1].x, rhi[1].y})), Sb1, Y, 0, 0, 0);
          Y = __builtin_amdgcn_mfma_f32_16x16x32_bf16(__builtin_bit_cast(bf16x8, ((u32x4){abr.x, abr.y, akr.x, akr.y})), UB, Y, 0, 0, 0);
#pragma unroll
          for (int jt = 0; jt < 4; ++jt) { const u32x2 bu = __builtin_bit_cast(u32x2, bhf[jt]), ku = __builtin_bit_cast(u32x2, khf[jt]);
            S[jt] = __builtin_amdgcn_mfma_f32_16x16x32_bf16(__builtin_bit_cast(bf16x8, ((u32x4){bu.x, bu.y, ku.x, ku.y})), UB, S[jt], 0, 0, 0) * gm[jt]; }
          { const int ps = nb * 4 + sc, tile = dir ? 127 - ps : ps;
            *(f32x4*)(yd + ((((size_t)dir * 128 + b * 8 + h) * 128 + tile) * 4 + wid) * 256 + lane * 4) = Y; }
        }
      }
    }
  }
}

#undef XT_LOAD
__device__ void phase_rwkv_post(const Params& P, LAS unsigned char* lds) {
  const GB gws = GB_WS(P), gout = GB_OUT(P);
  constexpr int L_SIG = 0, L_MUG = 16384, L_OUT = 20480;
  const bf16_t* Pm = (const bf16_t*)(P.ws + WS_P); const bf16_t* gupT = (const bf16_t*)(P.ws + WS_GUPT); const bf16_t* vblk = (const bf16_t*)(P.ws + WS_VBLK);
  const float* yd = P.out; const float* sd = (const float*)(P.ws + WS_SD); bf16_t* RY = (bf16_t*)(P.ws + WS_RY);
  int tid_ = threadIdx.x; asm volatile("" : "+v"(tid_));
  const int tid = tid_, wid = __builtin_amdgcn_readfirstlane(tid >> 6), lane = tid & 63, fr = lane & 15, fq = lane >> 4;
  const int tok_s = tid >> 3, cch = tid & 7, h = wid;
  LAS float* mug = (LAS float*)(lds + L_MUG);
  __syncthreads();
  if (tid < 256) mug[tid] = P.in[3 + (tid >> 7)][C_GL + (tid & 127)];
  bf16x8 bg[4][4];
#pragma unroll
  for (int ct = 0; ct < 4; ++ct)
#pragma unroll
    for (int ks = 0; ks < 4; ++ks) bg[ct][ks] = __builtin_bit_cast(bf16x8, ld16(gws, gupT + (size_t)(h * 64 + 16 * ct + fr) * 128 + ks * 32 + fq * 8));
  float lg[4], lb[4];
#pragma unroll
  for (int ct = 0; ct < 4; ++ct) { lg[ct] = P.in[17][h * 64 + 16 * ct + fr]; lb[ct] = P.in[18][h * 64 + 16 * ct + fr]; }
  struct PostIn { f32x4 yf[4], yb[4]; u32x2 vw[4]; f32x4 sf, sb; };
#define POST_LOAD(R, ITEM, MT) do { const int b_ = (ITEM) >> 5, t0_ = ((ITEM) & 31) * 64, tile_ = (t0_ >> 4) + (MT); const size_t bh_ = (size_t)b_ * 8 + h; \
    _Pragma("unroll") for (int ct_ = 0; ct_ < 4; ++ct_) { \
      R.yf[ct_] = ld16f(gout, yd + ((bh_ * 128 + tile_) * 4 + ct_) * 256 + lane * 4); \
      R.yb[ct_] = ld16f(gout, yd + ((((size_t)128 + bh_) * 128 + tile_) * 4 + ct_) * 256 + (fr + 16 * (3 - fq)) * 4);     \
      R.vw[ct_] = ld8(gws, vblk + ((bh_ * 128 + tile_) * 4 + ct_) * 256 + lane * 4); } \
    R.sf = ld16f(gws, sd + bh_ * T + t0_ + 16 * (MT) + 4 * fq); R.sb = ld16f(gws, sd + (128 + bh_) * T + t0_ + 16 * (MT) + 4 * fq); } while (0)
  PostIn cur, nxt;
  if ((int)blockIdx.x < NTOK / 64) POST_LOAD(cur, (int)blockIdx.x, 0);
  for (int item = blockIdx.x; item < NTOK / 64; item += gridDim.x) {
    const int b = item >> 5, t0 = (item & 31) * 64;
    __syncthreads();
    { const int tt = t0 + tok_s; const bf16_t* rowp = Pm + ptok(b * T + tt); const bf16_t* rowpp = Pm + ptok(b * T + tt - (tt > 0 ? 1 : 0)); const bf16_t* rowpn = Pm + ptok(b * T + tt + (tt < T - 1 ? 1 : 0)); const bool hp = tt > 0, hn = tt < T - 1;
#pragma unroll
      for (int half = 0; half < 2; ++half) { const int ch = cch + 8 * half;
        const u32x4 z4 = (u32x4){0u, 0u, 0u, 0u};
        const unsigned co = pcol(C_GL + ch * 8);
        const u32x4 c4 = ld16(gws, rowp + co); const u32x4 p4 = hp ? ld16(gws, rowpp + co) : z4; const u32x4 n4 = hn ? ld16(gws, rowpn + co) : z4;
        float cf[8], pf[8], nf[8], val[8]; unpack8f(c4, cf); unpack8f(p4, pf); unpack8f(n4, nf);
#pragma unroll
        for (int j = 0; j < 8; ++j) val[j] = sigmoidf_(cf[j] + mug[ch * 8 + j] * (pf[j] - cf[j]) + mug[128 + ch * 8 + j] * (nf[j] - cf[j]));
        u32x4 w; w.x = cvt_pk_bf16(val[0], val[1]); w.y = cvt_pk_bf16(val[2], val[3]); w.z = cvt_pk_bf16(val[4], val[5]); w.w = cvt_pk_bf16(val[6], val[7]);
        *(LAS u32x4*)(lds + L_SIG + tok_s * 256 + ((ch ^ (tok_s & 7)) << 4)) = w; } }
    __syncthreads();
#pragma unroll 1
    for (int mt = 0; mt < 4; ++mt) {
      if (mt < 3) POST_LOAD(nxt, item, mt + 1); else if (item + (int)gridDim.x < NTOK / 64) POST_LOAD(nxt, item + (int)gridDim.x, 0);
      const f32x4 sf = cur.sf, sb = cur.sb;
      f32x4 g[4];
      { const int trow = 16 * mt + fr;
        bf16x8 af[4];
#pragma unroll
        for (int ks = 0; ks < 4; ++ks) af[ks] = *(const LAS bf16x8*)(lds + L_SIG + trow * 256 + (((ks * 4 + fq) ^ (trow & 7)) << 4));
#pragma unroll
        for (int ct = 0; ct < 4; ++ct) { f32x4 c = (f32x4){0.f, 0.f, 0.f, 0.f};
#pragma unroll
          for (int ks = 0; ks < 4; ++ks) c = __builtin_amdgcn_mfma_f32_16x16x32_bf16(af[ks], bg[ct][ks], c, 0, 0, 0);
          g[ct] = c; } }
      f32x4 y[4];
#pragma unroll
      for (int ct = 0; ct < 4; ++ct) y[ct] = cur.yf[ct] + (f32x4){cur.yb[ct][3], cur.yb[ct][2], cur.yb[ct][1], cur.yb[ct][0]};
      f32x4 sm4 = (y[0] + y[1]) + (y[2] + y[3]);
#pragma unroll
      for (int rg = 0; rg < 4; ++rg) { float x = sm4[rg]; x = sum16(x); sm4[rg] = x * (1.f / 64.f); }
      f32x4 vr = (f32x4){0.f, 0.f, 0.f, 0.f};
#pragma unroll
      for (int ct = 0; ct < 4; ++ct) { y[ct] = y[ct] - sm4; vr += y[ct] * y[ct]; }
#pragma unroll
      for (int rg = 0; rg < 4; ++rg) { float x = vr[rg]; x = sum16(x); vr[rg] = __builtin_amdgcn_rsqf(x * (1.f / 64.f) + 64e-5f); }
      const f32x4 bs = sf + sb;
      LAS unsigned char* ot = lds + L_OUT + wid * 2048;
#pragma unroll
      for (int ct = 0; ct < 4; ++ct) {
        const f32x4 v4 = (f32x4){__uint_as_float(cur.vw[ct].x << 16), __uint_as_float(cur.vw[ct].x & 0xffff0000u), __uint_as_float(cur.vw[ct].y << 16), __uint_as_float(cur.vw[ct].y & 0xffff0000u)};
        const f32x4 o = ((y[ct] * vr) * lg[ct] + lb[ct] + bs * v4) * g[ct];
#pragma unroll
        for (int rg = 0; rg < 4; ++rg) *(LAS bf16_t*)(ot + (4 * fq + rg) * 128 + (16 * ct + fr) * 2) = f2bf(o[rg]);
      }
      asm volatile("s_waitcnt lgkmcnt(0)" ::: "memory");
#pragma unroll
      for (int i = 0; i < 2; ++i) { const int e = lane + 64 * i, r = e >> 3, ch = e & 7;
        const u32x4 w = *(const LAS u32x4*)(ot + r * 128 + ch * 16);
        *(u32x4*)(RY + (size_t)(b * T + t0 + 16 * mt + r) * D + h * 64 + ch * 8) = w; }
      asm volatile("" ::: "memory");
      cur = nxt;
    }
  }
#undef POST_LOAD
}

__device__ void phase_na(const Params& P, LAS unsigned char* lds, int G, int vcu) {
  const GB gws = GB_WS(P);
  const bf16_t* Pm = (const bf16_t*)(P.ws + WS_P); bf16_t* NY = (bf16_t*)(P.ws + WS_NY);
  const float* q_gain = P.in[19]; const float* k_gain = P.in[20]; const float* rpb = P.in[21];
  int tid_ = threadIdx.x; asm volatile("" : "+v"(tid_));
  const int tid = tid_, wid = __builtin_amdgcn_readfirstlane(tid >> 6), lane = tid & 63, fr = lane & 15, fq = lane >> 4;
  constexpr int KOFF = 0, VOFF = 61440, BOFF = 122880;
  LAS float* biasS = (LAS float*)(lds + BOFF);
  float kg[8], qg0[8], qg1[8];
#pragma unroll
  for (int j = 0; j < 8; ++j) { kg[j] = k_gain[(tid & 7) * 8 + j]; qg0[j] = q_gain[fq * 8 + j]; qg1[j] = q_gain[32 + fq * 8 + j]; }
  u32x4 kc[8], vc[8], qraw0, qraw1;
#define NA_GEOM(ITEM) const int cb = (ITEM) & 3, rq = ((ITEM) >> 2) & 3, h = ((ITEM) >> 4) & 7, b = (ITEM) >> 7; const int i0 = rq * 8; \
    const int kr0 = i0 >= 4 ? i0 - 4 : 0; const int krl = i0 + 3 > 24 ? 24 : i0 + 3; const int nkr = krl + 8 - kr0; \
    const int kb = cb == 0 ? 0 : (cb == 1 ? 8 : (cb == 2 ? 24 : 32)); const int nch = nkr * 256;
#define NA_LOAD(ITEM) do { NA_GEOM(ITEM) \
    _Pragma("unroll") for (int it = 0; it < 8; ++it) { const int e = tid + it * NTHR; \
      if (e < nch) { const int row = e >> 3; const size_t tok = (size_t)b * T + (kr0 + (row >> 5)) * 64 + kb + (row & 31); \
        const bf16_t* base = Pm + ptok((int)tok); const int hc_ = h * 64 + (e & 7) * 8; kc[it] = ld16(gws, base + pcol(C_NK + hc_)); vc[it] = ld16(gws, base + pcol(C_NV + hc_)); } } \
    { const bf16_t* qp_ = Pm + ptok(b * T + (i0 + wid) * 64 + cb * 16 + fr); qraw0 = ld16(gws, qp_ + pcol(C_Q + h * 64 + fq * 8)); qraw1 = ld16(gws, qp_ + pcol(C_Q + h * 64 + 32 + fq * 8)); } } while (0)
  if (vcu < 2048) NA_LOAD(vcu);
  for (int item = vcu; item < 2048; item += G) {
    NA_GEOM(item)
    __syncthreads();
    if (tid < 465) biasS[tid] = rpb[h * 465 + tid];
#pragma unroll
    for (int it = 0; it < 8; ++it) { const int e = tid + it * NTHR;
      if (e < nch) { const int row = e >> 3; float f[8]; unpack8f(kc[it], f);
        float ss = 0.f;
#pragma unroll
        for (int j = 0; j < 8; ++j) ss += f[j] * f[j];
        ss = sum8(ss);
        const float sc = __builtin_amdgcn_rsqf(ss * (1.f / 64.f) + 1e-6f);
        u32x4 w; w.x = cvt_pk_bf16(f[0] * sc * kg[0], f[1] * sc * kg[1]); w.y = cvt_pk_bf16(f[2] * sc * kg[2], f[3] * sc * kg[3]);
        w.z = cvt_pk_bf16(f[4] * sc * kg[4], f[5] * sc * kg[5]); w.w = cvt_pk_bf16(f[6] * sc * kg[6], f[7] * sc * kg[7]);
        const int off = row * 128 + (((e & 7) ^ (row & 7)) << 4);
        *(LAS u32x4*)(lds + KOFF + off) = w; *(LAS u32x4*)(lds + VOFF + off) = vc[it]; } }
    const u32x4 qc0 = qraw0, qc1 = qraw1;
    if (item + G < 2048) NA_LOAD(item + G);
    __syncthreads();
    const int i = i0 + wid;
    const size_t qtok = (size_t)b * T + i * 64 + cb * 16 + fr;
    bf16x8 qf0, qf1;
    { float f0[8], f1[8]; unpack8f(qc0, f0); unpack8f(qc1, f1);
      float ss = 0.f;
#pragma unroll
      for (int j = 0; j < 8; ++j) ss += f0[j] * f0[j] + f1[j] * f1[j];
      ss += __shfl_xor(ss, 16); ss += __shfl_xor(ss, 32);
      const float sc = __builtin_amdgcn_rsqf(ss * (1.f / 64.f) + 1e-6f) * 0.125f;
      u32x4 w0, w1;
      w0.x = cvt_pk_bf16(f0[0] * sc * qg0[0], f0[1] * sc * qg0[1]); w0.y = cvt_pk_bf16(f0[2] * sc * qg0[2], f0[3] * sc * qg0[3]);
      w0.z = cvt_pk_bf16(f0[4] * sc * qg0[4], f0[5] * sc * qg0[5]); w0.w = cvt_pk_bf16(f0[6] * sc * qg0[6], f0[7] * sc * qg0[7]);
      w1.x = cvt_pk_bf16(f1[0] * sc * qg1[0], f1[1] * sc * qg1[1]); w1.y = cvt_pk_bf16(f1[2] * sc * qg1[2], f1[3] * sc * qg1[3]);
      w1.z = cvt_pk_bf16(f1[4] * sc * qg1[4], f1[5] * sc * qg1[5]); w1.w = cvt_pk_bf16(f1[6] * sc * qg1[6], f1[7] * sc * qg1[7]);
      qf0 = __builtin_bit_cast(bf16x8, w0); qf1 = __builtin_bit_cast(bf16x8, w1); }
    int rs_i = i - 4; rs_i = rs_i < 0 ? 0 : (rs_i > 24 ? 24 : rs_i);
    const int lrow0 = rs_i - kr0;
    f32x4 acc[16];
    { const int sw = fr & 7;
      const int ka = KOFF + ((lrow0 * 32 + fr) * 128);
#pragma unroll
      for (int t = 0; t < 16; ++t) {
        const int addr = ka + ((t >> 1) * 32 + (t & 1) * 16) * 128;
        const bf16x8 a0 = *(const LAS bf16x8*)(lds + addr + ((fq ^ sw) << 4));
        const bf16x8 a1 = *(const LAS bf16x8*)(lds + addr + (((4 + fq) ^ sw) << 4));
        f32x4 c = (f32x4){0.f, 0.f, 0.f, 0.f};
        c = __builtin_amdgcn_mfma_f32_16x16x32_bf16(a0, qf0, c, 0, 0, 0);
        acc[t] = __builtin_amdgcn_mfma_f32_16x16x32_bf16(a1, qf1, c, 0, 0, 0);
      } }
    const int qc = cb * 16 + fr;
    int cs = qc - 8; cs = cs < 0 ? 0 : (cs > 48 ? 48 : cs);
    const int dr0 = rs_i - i + 7;
    bool v0[4]; int dcs[4];
#pragma unroll
    for (int rg = 0; rg < 4; ++rg) { const int kcol0 = kb + 4 * fq + rg; v0[rg] = kcol0 >= cs; dcs[rg] = (v0[rg] ? kcol0 : kcol0 + 16) - qc + 15; }
    float mx = -3.0e38f;
#pragma unroll
    for (int s2 = 0; s2 < 8; ++s2)
#pragma unroll
      for (int rg = 0; rg < 4; ++rg) {
        const float sv = (v0[rg] ? acc[2 * s2][rg] : acc[2 * s2 + 1][rg]) + biasS[(dr0 + s2) * 31 + dcs[rg]];
        acc[2 * s2][rg] = sv; mx = fmaxf(mx, sv);
      }
    mx = fmaxf(mx, __shfl_xor(mx, 16)); mx = fmaxf(mx, __shfl_xor(mx, 32));
    float sum = 0.f;
#pragma unroll
    for (int s2 = 0; s2 < 8; ++s2)
#pragma unroll
      for (int rg = 0; rg < 4; ++rg) { const float pv = __expf(acc[2 * s2][rg] - mx); sum += pv; acc[2 * s2][rg] = v0[rg] ? pv : 0.f; acc[2 * s2 + 1][rg] = v0[rg] ? 0.f : pv; }
    sum += __shfl_xor(sum, 16); sum += __shfl_xor(sum, 32);
    f32x4 o[4];
#pragma unroll
    for (int db = 0; db < 4; ++db) o[db] = (f32x4){0.f, 0.f, 0.f, 0.f};
    { const int row1 = lrow0 * 32 + 4 * fq + (fr >> 2);
      const int pq = fr & 3;
#pragma unroll
      for (int s2 = 0; s2 < 8; ++s2) {
        u32x4 pw; pw.x = cvt_pk_bf16(acc[2 * s2][0], acc[2 * s2][1]); pw.y = cvt_pk_bf16(acc[2 * s2][2], acc[2 * s2][3]);
        pw.z = cvt_pk_bf16(acc[2 * s2 + 1][0], acc[2 * s2 + 1][1]); pw.w = cvt_pk_bf16(acc[2 * s2 + 1][2], acc[2 * s2 + 1][3]);
        const bf16x8 pb = __builtin_bit_cast(bf16x8, pw);
        const int rowv = row1 + s2 * 32;
        s16x4 lo[4], hi[4];
#pragma unroll
        for (int db = 0; db < 4; ++db) {
          const int va = VOFF + rowv * 128 + (((db * 2 + (pq >> 1)) ^ (rowv & 7)) << 4) + (pq & 1) * 8;
          lo[db] = lds_tr16(lds, va); hi[db] = lds_tr16(lds, va + 2048);
        }
#pragma unroll
        for (int db = 0; db < 4; ++db) {
          const bf16x8 va8 = (bf16x8){lo[db][0], lo[db][1], lo[db][2], lo[db][3], hi[db][0], hi[db][1], hi[db][2], hi[db][3]};
          o[db] = __builtin_amdgcn_mfma_f32_16x16x32_bf16(va8, pb, o[db], 0, 0, 0);
        }
      } }
    const float inv = __builtin_amdgcn_rcpf(sum);
    bf16_t* op = NY + qtok * D + h * 64 + 4 * fq;
#pragma unroll
    for (int db = 0; db < 4; ++db) { u32x2 w; w.x = cvt_pk_bf16(o[db][0] * inv, o[db][1] * inv); w.y = cvt_pk_bf16(o[db][2] * inv, o[db][3] * inv); *(u32x2*)(op + db * 16) = w; }
  }
}

__device__ void phase_router(const Params& P, float* sm) {
  const GB gws = GB_WS(P), gout = GB_OUT(P);
  { const ExpDesc ed{P.in[31], P.in[32], P.in[33], P.ws}; transpose_items((int)blockIdx.x + XT_PER_WG * (int)gridDim.x, ExpDesc::COUNT, (int)gridDim.x, ed, sm); }
  const float* g2 = P.in[26]; const float* w_rg = P.in[27]; const float* b_rg = P.in[28]; const float* w_re = P.in[29]; const float* b_re = P.in[30];
  bf16_t* H2 = (bf16_t*)P.out; const bf16_t* DL = (const bf16_t*)(P.ws + WS_DELTA); int* EID = (int*)(P.ws + WS_EID); float* EW = (float*)(P.ws + WS_EW); int* RANK = (int*)(P.ws + WS_RANK); int* CNT = (int*)(P.ws + WS_CNT);
  float* RSG = (float*)(P.ws + WS_RSG);
  constexpr int XSTR = 260;
  float* xs = sm;
  float* wsm = sm + 64 * XSTR;
  float* rsm = wsm + 256 * 48;
  float* lgm = rsm + 64;
  int tid_ = threadIdx.x; asm volatile("" : "+v"(tid_));
  const int tid = tid_, wid = __builtin_amdgcn_readfirstlane(tid >> 6), lane = tid & 63, fr = lane & 15, fq = lane >> 4;
  const int tok_s = tid >> 3, seg = tid & 7;
  const bool heavy = wid < 4; const int mt = wid & 3;
  for (int item = blockIdx.x; item < NTOK / 64; item += gridDim.x) {
    const int tok0 = item * 64;
    f32x4 acc0 = (f32x4){0.f, 0.f, 0.f, 0.f}, acc1 = acc0;
    float ss = 0.f;
    const float* xrow = P.in[0] + (size_t)(tok0 + tok_s) * D + seg * 4; const bf16_t* drow = DL + (size_t)(tok0 + tok_s) * D + seg * 4; const f32x4* wrp = (const f32x4*)(P.ws + WS_WR) + tid;
    f32x4 xq[8], wq[6]; u32x2 dq[8];
#pragma unroll
    for (int j = 0; j < 8; ++j) { xq[j] = __builtin_nontemporal_load((const f32x4*)(xrow + j * 32)); dq[j] = ld8(gws, drow + j * 32); }
#pragma unroll
    for (int i = 0; i < 6; ++i) wq[i] = ld16f(gws, wrp + i * NTHR);
    for (int kc = 0; kc < 4; ++kc) {
      __syncthreads();
      { const float* gr = g2 + kc * 256 + seg * 4; bf16_t* hr = H2 + (size_t)(tok0 + tok_s) * D + kc * 256 + seg * 4;
#pragma unroll
        for (int j = 0; j < 8; ++j) { const f32x4 g = *(const f32x4*)(gr + j * 32);
          const f32x4 x = xq[j] + (f32x4){__uint_as_float(dq[j].x << 16), __uint_as_float(dq[j].x & 0xffff0000u), __uint_as_float(dq[j].y << 16), __uint_as_float(dq[j].y & 0xffff0000u)};
          ss += x[0] * x[0] + x[1] * x[1] + x[2] * x[2] + x[3] * x[3];
          const f32x4 xg = x * g;
          *(f32x4*)(xs + tok_s * XSTR + j * 32 + seg * 4) = xg;
          u32x2 w; w.x = cvt_pk_bf16(xg[0], xg[1]); w.y = cvt_pk_bf16(xg[2], xg[3]); *(u32x2*)(hr + j * 32) = w; }
#pragma unroll
        for (int i = 0; i < 6; ++i) *(f32x4*)(wsm + (tid + i * NTHR) * 4) = wq[i]; }
      if (kc < 3) {
#pragma unroll
        for (int j = 0; j < 8; ++j) { xq[j] = __builtin_nontemporal_load((const f32x4*)(xrow + (kc + 1) * 256 + j * 32)); dq[j] = ld8(gws, drow + (kc + 1) * 256 + j * 32); }
#pragma unroll
        for (int i = 0; i < 6; ++i) wq[i] = ld16f(gws, wrp + (kc + 1) * 3072 + i * NTHR); }
      __syncthreads();
      { const float* ap = xs + (16 * mt + fr) * XSTR + fq; const float* bp = wsm + fq * 48 + fr + (heavy ? 0 : 32);
        if (heavy) {
#pragma unroll 8
          for (int ks = 0; ks < 64; ++ks) { const float a = ap[4 * ks]; const float b0 = bp[ks * 192], b1 = bp[ks * 192 + 16];
            acc0 = __builtin_amdgcn_mfma_f32_16x16x4f32(a, b0, acc0, 0, 0, 0); acc1 = __builtin_amdgcn_mfma_f32_16x16x4f32(a, b1, acc1, 0, 0, 0); }
        } else {
#pragma unroll 8
          for (int ks = 0; ks < 64; ++ks) { const float a = ap[4 * ks]; const float b2 = bp[ks * 192];
            acc0 = __builtin_amdgcn_mfma_f32_16x16x4f32(a, b2, acc0, 0, 0, 0); }
        } }
    }
    ss = sum8(ss);
    if (seg == 0) { const float rs = __builtin_amdgcn_rsqf(ss * (1.f / D) + 1e-6f); rsm[tok_s] = rs; RSG[tok0 + tok_s] = rs; }
    __syncthreads();
    { const int o0 = heavy ? fr : 32 + fr;
#pragma unroll
      for (int rg = 0; rg < 4; ++rg) { const int tk = 16 * mt + 4 * fq + rg; const float rs = rsm[tk];
        if (heavy) { lgm[tk * 48 + fr] = acc0[rg] * rs + b_re[fr]; lgm[tk * 48 + 16 + fr] = acc1[rg] * rs + b_re[16 + fr]; }
        else if (fr < 4) lgm[tk * 48 + o0] = acc0[rg] * rs + b_rg[fr]; } }
    __syncthreads();
    if (tid < 64) {
      const int tok = tok0 + tid; const float* gl = lgm + tid * 48 + 32;
      int gs = 0; float gm = gl[0];
      for (int o = 1; o < 4; ++o) if (gl[o] > gm) { gm = gl[o]; gs = o; }
      float den = 0.f; for (int o = 0; o < 4; ++o) den += __expf(gl[o] - gm);
      const float pg = 1.f / den;
      const float* e = lgm + tid * 48 + gs * 8;
      int i0 = 0; float v0 = e[0];
      for (int o = 1; o < 8; ++o) if (e[o] > v0) { v0 = e[o]; i0 = o; }
      int i1 = -1; float v1 = -3.0e38f;
      for (int o = 0; o < 8; ++o) if (o != i0 && e[o] > v1) { v1 = e[o]; i1 = o; }
      const float w0 = 1.f / (1.f + __expf(v1 - v0));
      const int e0 = gs * 8 + i0, e1 = gs * 8 + i1;
      EID[tok * 2] = e0; EID[tok * 2 + 1] = e1;
      EW[tok * 2] = pg * w0; EW[tok * 2 + 1] = pg * (1.f - w0);
      const int r0 = atomicAdd(&CNT[e0], 1), r1 = atomicAdd(&CNT[e1], 1);
      RANK[tok * 2] = r0; RANK[tok * 2 + 1] = r1;
      const float rs = rsm[tid];
      int* LTOK = (int*)(P.ws + WS_LTOK); float* LW = (float*)(P.ws + WS_LW); float* LRS = (float*)(P.ws + WS_LRS);
      const size_t j0 = (size_t)e0 * NTOK + r0, j1 = (size_t)e1 * NTOK + r1;
      LTOK[j0] = tok; LW[j0] = pg * w0; LRS[j0] = rs; LTOK[j1] = tok; LW[j1] = pg * (1.f - w0); LRS[j1] = rs;
    }
  }
}

__device__ void build_rtoff(const Params& P, LAS int* rtoff) {
  __syncthreads();
  if (threadIdx.x == 0) { const int* CNT = (const int*)(P.ws + WS_CNT); int acc = 0;
    for (int l = 0; l < 64; ++l) { const int c = __hip_atomic_load(&CNT[l], __ATOMIC_RELAXED, __HIP_MEMORY_SCOPE_AGENT); rtoff[l] = acc; rtoff[65 + l] = c; acc += (c + 255) >> 8; }
    rtoff[64] = acc; }
  __syncthreads();
  if (threadIdx.x < MAXRT) { const int rt = threadIdx.x; int l = 0; while (l < 63 && rtoff[l + 1] <= rt) ++l; rtoff[136 + rt] = l; }
  __syncthreads();
}

__device__ void phase_combine(const Params& P, const LAS int* rtoff) {
  const GB gws = GB_WS(P), gout = GB_OUT(P);
  const bf16_t* O = (const bf16_t*)(P.ws + WS_O); const bf16_t* DL = (const bf16_t*)(P.ws + WS_DELTA); const int* EID = (const int*)(P.ws + WS_EID); const int* RANK = (const int*)(P.ws + WS_RANK);
  int tid_ = threadIdx.x; asm volatile("" : "+v"(tid_));
  const int lane = tid_ & 63, gw = blockIdx.x * 8 + (tid_ >> 6), ngw = gridDim.x * 8;
  struct Rows { u32x4 a0, a1, b0, b1, d0, d1; f32x4 x[4]; };
  const int ntk = (NTOK - gw + ngw - 1) / ngw;
  for (int j0 = 0; j0 < ntk; j0 += 32) {
    int myrow = 0;
    { const int jt = j0 + (lane >> 1), tk = gw + jt * ngw;
      if (jt < ntk) myrow = rtoff[ld4i(gws, EID + tk * 2 + (lane & 1))] * 256 + ld4i(gws, RANK + tk * 2 + (lane & 1)); }
    const int nj = (ntk - j0) < 32 ? (ntk - j0) : 32;
    Rows cur, nxt;
#define CMB_LOAD(R, JJ) do { const int tk_ = gw + (j0 + (JJ)) * ngw; const int r0_ = __shfl(myrow, 2 * (JJ)), r1_ = __shfl(myrow, 2 * (JJ) + 1); \
      R.a0 = ld16(gws, O + (size_t)r0_ * D + lane * 16); R.a1 = ld16(gws, O + (size_t)r0_ * D + lane * 16 + 8); \
      R.b0 = ld16(gws, O + (size_t)r1_ * D + lane * 16); R.b1 = ld16(gws, O + (size_t)r1_ * D + lane * 16 + 8); \
      R.d0 = ld16(gws, DL + (size_t)tk_ * D + lane * 16); R.d1 = ld16(gws, DL + (size_t)tk_ * D + lane * 16 + 8); \
      _Pragma("unroll") for (int q_ = 0; q_ < 4; ++q_) R.x[q_] = __builtin_nontemporal_load((const f32x4*)(P.in[0] + (size_t)tk_ * D + lane * 16 + 4 * q_)); } while (0)
    CMB_LOAD(cur, 0);
    for (int jj = 0; jj < nj; ++jj) {
      if (jj + 1 < nj) CMB_LOAD(nxt, jj + 1);
      float fa[16], fb[16], fd[16];
      { float t[8]; unpack8f(cur.d0, t);
#pragma unroll
        for (int q = 0; q < 8; ++q) fd[q] = t[q];
        unpack8f(cur.d1, t);
#pragma unroll
        for (int q = 0; q < 8; ++q) fd[8 + q] = t[q];
        unpack8f(cur.a0, t);
#pragma unroll
        for (int q = 0; q < 8; ++q) fa[q] = t[q];
        unpack8f(cur.a1, t);
#pragma unroll
        for (int q = 0; q < 8; ++q) fa[8 + q] = t[q];
        unpack8f(cur.b0, t);
#pragma unroll
        for (int q = 0; q < 8; ++q) fb[q] = t[q];
        unpack8f(cur.b1, t);
#pragma unroll
        for (int q = 0; q < 8; ++q) fb[8 + q] = t[q]; }
      float* op = P.out + (size_t)(gw + (j0 + jj) * ngw) * D + lane * 16;
#pragma unroll
      for (int q4 = 0; q4 < 4; ++q4) { f32x4 o;
#pragma unroll
        for (int q = 0; q < 4; ++q) o[q] = ((cur.x[q4][q] + fd[4 * q4 + q]) + fa[4 * q4 + q]) + fb[4 * q4 + q];
        *(f32x4*)(op + 4 * q4) = o; }
      cur = nxt;
    }
#undef CMB_LOAD
  }
}

__global__ void __launch_bounds__(NTHR, 2) fwd_megakernel(Params P) {
  extern __shared__ __attribute__((aligned(16))) unsigned char lds[];
  float* sm = (float*)lds;
  LAS unsigned char* ldsl = (LAS unsigned char*)lds;
  LAS int* rtoff = (LAS int*)(ldsl + pg8::STAGE_BYTES);
  if (threadIdx.x < 4) ((LAS unsigned*)(ldsl + 147440))[threadIdx.x] = 0u;
  __syncthreads();
  (void)xcd_barrier_post((unsigned*)(P.ws + WS_BAR), (volatile LAS unsigned*)(ldsl + 147440));
#define GRID_BARRIER() do { XcdBarrier xb_; xb_.bar = (unsigned*)(P.ws + WS_BAR); xb_.x = 0u; xb_.st = (volatile LAS unsigned*)(ldsl + 147440); xcd_barrier(xb_); } while (0)
  const int G = gridDim.x, bx = blockIdx.x;
  const int vcu = (G % 8 == 0) ? (bx % 8) * (G / 8) + bx / 8 : bx;

  phase_prologue(P, sm);     GRID_BARRIER();
  { pg8::Gemm g{(const bf16_t*)(P.ws + WS_H), (const bf16_t*)(P.ws + WS_W1T), D}; pg8::StaticOrder S; S.init(NTOK, INCP, G, bx);
    EpiP E{(bf16_t*)(P.ws + WS_P), P.in[22], P.ws + WS_G8};
    pg8::gemm_phase(ldsl, g, S, E); }
  GRID_BARRIER();
  phase_na(P, ldsl, G, vcu);
  phase_scan(P, ldsl);           GRID_BARRIER();
  phase_rwkv_post(P, ldsl);  GRID_BARRIER();
  { pg8::StaticOrder S; S.init(NTOK, D, G, bx);
    pg8::Gemm g{(const bf16_t*)(P.ws + WS_RY), (const bf16_t*)(P.ws + WS_WOA), D};
    EpiMix E{P.ws + WS_G8, (bf16_t*)(P.ws + WS_MIX), GB_WS(P)};
    pg8::gemm_phase(ldsl, g, S, E); }
  GRID_BARRIER();
  { pg8::StaticOrder S; S.init(NTOK, D, G, bx);
    pg8::Gemm g{(const bf16_t*)(P.ws + WS_MIX), (const bf16_t*)(P.ws + WS_WOUT), D};
    EpiXout E{(bf16_t*)(P.ws + WS_DELTA)};
    pg8::gemm_phase(ldsl, g, S, E); }
  GRID_BARRIER();
  phase_router(P, sm);       GRID_BARRIER();
  build_rtoff(P, rtoff);
  { pg8::MoeOrder S{rtoff, 0, rtoff[64], 2, G, vcu, (const int*)(P.ws + WS_LTOK), GB_WS(P)};
    pg8::Gemm g{(const bf16_t*)P.out, (const bf16_t*)(P.ws + WS_WGU), D};
    EpiGateUp E{(bf16_t*)(P.ws + WS_HE), (const float*)(P.ws + WS_LRS), GB_WS(P)};
    pg8::gemm_phase<true>(ldsl, g, S, E); }
  GRID_BARRIER();
  { pg8::MoeOrder S{rtoff, 0, rtoff[64], 4, G, vcu, (const int*)(P.ws + WS_LTOK), GB_WS(P)};
    pg8::Gemm g{(const bf16_t*)(P.ws + WS_HE), (const bf16_t*)(P.ws + WS_WD), 256};
    EpiDown E{(const float*)(P.ws + WS_LW), (bf16_t*)(P.ws + WS_O), GB_WS(P)};
    pg8::gemm_phase(ldsl, g, S, E); }
  GRID_BARRIER();
  phase_combine(P, rtoff);
}

extern "C" void kernel_launch(void* const* d_in, const int* in_sizes, int n_in, void* d_out, int out_size,
                              void* d_ws, size_t ws_size, hipStream_t stream) {
  constexpr size_t kDynLds = 144 * 1024;
  static int grid_blocks = 0;
  if (!grid_blocks) {
    int dev = 0, cus = 0, per_cu = 0;
    (void)hipGetDevice(&dev);
    (void)hipDeviceGetAttribute(&cus, hipDeviceAttributeMultiprocessorCount, dev);
    (void)hipFuncSetAttribute((const void*)fwd_megakernel, hipFuncAttributeMaxDynamicSharedMemorySize, (int)kDynLds);
    (void)hipOccupancyMaxActiveBlocksPerMultiprocessor(&per_cu, fwd_megakernel, NTHR, kDynLds);
    if (n_in != 34 || out_size != NTOK * D || ws_size < WS_NEED || per_cu < 1) {
      fprintf(stderr, "kernel_launch: unexpected n_in %d out_size %d ws_size %zu per_cu %d\n", n_in, out_size, ws_size, per_cu);
      grid_blocks = -1; return;
    }
    grid_blocks = cus;
  }
  if (grid_blocks < 0) return;
  (void)hipMemsetAsync((unsigned char*)d_ws + WS_BAR, 0, XCD_BAR_WORDS * 4, stream);
  Params p{};
  for (int i = 0; i < 34; ++i) p.in[i] = (const float*)d_in[i];
  p.out = (float*)d_out; p.ws = (unsigned char*)d_ws;
  void* args[] = {&p};
  hipError_t e = hipLaunchCooperativeKernel((void*)fwd_megakernel, dim3(grid_blocks), dim3(NTHR), args, kDynLds, stream);
  if (e != hipSuccess) fprintf(stderr, "cooperative launch failed: %s (grid %d)\n", hipGetErrorString(e), grid_blocks);
}
```
